# Optimizing an MI355X kernel written in HIP

```python
import math
import jax, jax.numpy as jnp
from jax import lax
import numpy as np

D_MODEL = 1024
BATCH = 2
SEQ = 8192
DEPTH = 1

SB_HEADS = 8
SB_HEAD_DIM = 64
SB_WIDTH = SB_HEADS * SB_HEAD_DIM
MLA_HEADS = 8
MLA_NOPE_DIM = 64
MLA_ROPE_DIM = 32
MLA_QK_DIM = MLA_NOPE_DIM + MLA_ROPE_DIM
MLA_V_DIM = 64
MLA_WIDTH = MLA_HEADS * MLA_V_DIM
Q_LORA_RANK = 384
KV_LORA_RANK = 256
ROPE_THETA = 10000.0
MIX_WIDTH = SB_WIDTH + MLA_WIDTH
Q_BLOCK = 128
EPS = 1e-6
IN_SIZES = (SB_WIDTH, SB_WIDTH, SB_WIDTH, SB_WIDTH,
            Q_LORA_RANK, KV_LORA_RANK, MLA_ROPE_DIM, MLA_WIDTH)
IN_COLS = sum(IN_SIZES)

kernel_name = "hymba_stickbreaking_mla_adaln"


def _rms_norm(x, w):
    xf = x.astype(jnp.float32)
    y = xf * lax.rsqrt(jnp.mean(xf * xf, axis=-1, keepdims=True) + EPS)
    return (y * w.astype(jnp.float32)).astype(x.dtype)


def _rotate_half(x):
    x1, x2 = jnp.split(x, 2, axis=-1)
    return jnp.concatenate([-x2, x1], axis=-1)


def _to_blocks(q):
    B, H, S, d = q.shape
    return q.reshape(B, H, S // Q_BLOCK, Q_BLOCK, d).transpose(2, 0, 1, 3, 4)


def _from_blocks(o):
    nb, B, H, QB, d = o.shape
    return o.transpose(1, 2, 0, 3, 4).reshape(B, H, nb * QB, d)


def _stick_breaking_attention(q, k, v):
    S, d = q.shape[2], q.shape[3]
    key_pos = jnp.arange(S)
    inv_sqrt_d = 1.0 / math.sqrt(d)

    def block(args):
        i, qi = args
        q_pos = i * Q_BLOCK + jnp.arange(Q_BLOCK)
        z = jnp.einsum('bhqd,bhkd->bhqk', qi, k).astype(jnp.float32) * inv_sqrt_d
        strict = key_pos[None, :] < q_pos[:, None]
        log_keep = jnp.where(strict, jax.nn.log_sigmoid(-z), 0.0)
        after = lax.cumsum(log_keep, axis=3, reverse=True) - log_keep
        w = jnp.where(strict, jnp.exp(jax.nn.log_sigmoid(z) + after), 0.0)
        return jnp.einsum('bhqk,bhkd->bhqd', w.astype(v.dtype), v)

    out = lax.map(block, (jnp.arange(S // Q_BLOCK), _to_blocks(q)))
    return _from_blocks(out)


def _causal_softmax_attention(q, k, v):
    S, d = q.shape[2], q.shape[3]
    key_pos = jnp.arange(S)
    scale = 1.0 / math.sqrt(d)
    neg = jnp.finfo(jnp.float32).min

    def block(args):
        i, qi = args
        q_pos = i * Q_BLOCK + jnp.arange(Q_BLOCK)
        z = jnp.einsum('bhqd,bhkd->bhqk', qi, k).astype(jnp.float32) * scale
        causal = key_pos[None, :] <= q_pos[:, None]
        p = jax.nn.softmax(jnp.where(causal, z, neg), axis=-1)
        return jnp.einsum('bhqk,bhkd->bhqd', p.astype(v.dtype), v)

    out = lax.map(block, (jnp.arange(S // Q_BLOCK), _to_blocks(q)))
    return _from_blocks(out)


def _layer(x, c, cos, sin, w_ada, b_ada, norm_w, w_in, q_lora_norm, w_uq,
           kv_lora_norm, w_ukv, q_head_norm, k_head_norm, w_out):
    B, S, _ = x.shape
    ada = jax.nn.silu(c) @ w_ada + b_ada
    shift, scale, gate = jnp.split(ada[:, None, :], 3, axis=-1)
    h = _rms_norm(x, norm_w) * (1.0 + scale) + shift

    proj = h @ w_in
    q_sb, k_sb, v_sb, g_sb, c_q, c_kv, k_rope, g_mla = jnp.split(
        proj, np.cumsum(IN_SIZES)[:-1].tolist(), axis=-1)

    def heads_sb(t):
        return t.reshape(B, S, SB_HEADS, SB_HEAD_DIM).transpose(0, 2, 1, 3)
    o_sb = _stick_breaking_attention(heads_sb(q_sb), heads_sb(k_sb), heads_sb(v_sb))
    o_sb = o_sb.transpose(0, 2, 1, 3).reshape(B, S, SB_WIDTH) * jax.nn.silu(g_sb)

    q = (_rms_norm(c_q, q_lora_norm) @ w_uq).reshape(B, S, MLA_HEADS, MLA_QK_DIM)
    kv = (_rms_norm(c_kv, kv_lora_norm) @ w_ukv).reshape(
        B, S, MLA_HEADS, MLA_NOPE_DIM + MLA_V_DIM)
    k_nope, v_mla = kv[..., :MLA_NOPE_DIM], kv[..., MLA_NOPE_DIM:]
    k_r = jnp.broadcast_to(k_rope[:, :, None, :], (B, S, MLA_HEADS, MLA_ROPE_DIM))
    k = jnp.concatenate([k_nope, k_r], axis=-1)
    q = _rms_norm(q, q_head_norm)
    k = _rms_norm(k, k_head_norm)
    def rope(t):
        t_n, t_r = t[..., :MLA_NOPE_DIM], t[..., MLA_NOPE_DIM:]
        t_r = t_r * cos + _rotate_half(t_r) * sin
        return jnp.concatenate([t_n, t_r], axis=-1)
    q, k = rope(q), rope(k)
    o_mla = _causal_softmax_attention(q.transpose(0, 2, 1, 3), k.transpose(0, 2, 1, 3),
                                      v_mla.transpose(0, 2, 1, 3))
    o_mla = o_mla.transpose(0, 2, 1, 3).reshape(B, S, MLA_WIDTH) * jax.nn.silu(g_mla)

    mixed = jnp.concatenate([o_sb, o_mla], axis=-1)
    return x + gate * (mixed @ w_out)


def setup_inputs(seed: int = 0) -> dict:
    key = jax.random.key(seed)
    ks = jax.random.split(key, 16)
    D = D_MODEL

    def nrm(k, shape, std):
        return jax.random.normal(k, shape, jnp.float32) * std

    def gain(k, n):
        return 1.0 + 0.01 * jax.random.normal(k, (DEPTH, n), jnp.float32)

    return {
        "x": nrm(ks[0], (BATCH, SEQ, D), 1.0),
        "c": nrm(ks[1], (BATCH, D), 1.0),
        "positions": jnp.broadcast_to(jnp.arange(SEQ, dtype=jnp.int32), (BATCH, SEQ)),
        "w_ada": nrm(ks[2], (DEPTH, D, 3 * D), 0.5 * D ** -0.5),
        "b_ada": nrm(ks[3], (DEPTH, 3 * D), 0.01),
        "norm_w": gain(ks[4], D),
        "w_in": nrm(ks[5], (DEPTH, D, IN_COLS), D ** -0.5),
        "q_lora_norm": gain(ks[6], Q_LORA_RANK),
        "w_uq": nrm(ks[7], (DEPTH, Q_LORA_RANK, MLA_HEADS * MLA_QK_DIM), Q_LORA_RANK ** -0.5),
        "kv_lora_norm": gain(ks[8], KV_LORA_RANK),
        "w_ukv": nrm(ks[9], (DEPTH, KV_LORA_RANK, MLA_HEADS * (MLA_NOPE_DIM + MLA_V_DIM)),
                     KV_LORA_RANK ** -0.5),
        "q_head_norm": gain(ks[10], MLA_QK_DIM),
        "k_head_norm": gain(ks[11], MLA_QK_DIM),
        "w_out": nrm(ks[12], (DEPTH, MIX_WIDTH, D), MIX_WIDTH ** -0.5),
    }


def reference(x, c, positions, w_ada, b_ada, norm_w, w_in, q_lora_norm, w_uq,
              kv_lora_norm, w_ukv, q_head_norm, k_head_norm, w_out):
    inv_freq = ROPE_THETA ** (-jnp.arange(0, MLA_ROPE_DIM, 2, dtype=jnp.float32) / MLA_ROPE_DIM)
    ang = positions.astype(jnp.float32)[..., None] * inv_freq
    ang = jnp.concatenate([ang, ang], axis=-1)[:, :, None, :]
    cos = jnp.cos(ang).astype(x.dtype)
    sin = jnp.sin(ang).astype(x.dtype)
    for l in range(DEPTH):
        x = _layer(x, c, cos, sin, w_ada[l], b_ada[l], norm_w[l], w_in[l],
                   q_lora_norm[l], w_uq[l], kv_lora_norm[l], w_ukv[l],
                   q_head_norm[l], k_head_norm[l], w_out[l])
    return x
```

```cpp
#include <hip/hip_runtime.h>
#include <hip/hip_cooperative_groups.h>
#include <cstdio>
#include <cstdint>
namespace cg = cooperative_groups;

#ifndef ONE_LAUNCH
#define ONE_LAUNCH 0
#endif

typedef unsigned short bf16_t;
typedef short bf16x8 __attribute__((ext_vector_type(8)));
typedef short s16x4 __attribute__((ext_vector_type(4)));
typedef float f32x16 __attribute__((ext_vector_type(16)));
typedef float f32x4 __attribute__((ext_vector_type(4)));
typedef float f32x2 __attribute__((ext_vector_type(2)));
typedef __bf16 bf2_t __attribute__((ext_vector_type(2)));
typedef unsigned u32x4 __attribute__((ext_vector_type(4)));
typedef unsigned u32x2 __attribute__((ext_vector_type(2)));
typedef __attribute__((address_space(3))) s16x4 lds_s16x4;

#define DI __device__ __forceinline__
#define MFMA32(a, b, c) __builtin_amdgcn_mfma_f32_32x32x16_bf16((a), (b), (c), 0, 0, 0)

constexpr int S_ = 8192, NTOK = 16384, DM = 1024, INC = 3232, INPAD = 3328;
constexpr float LOG2E = 1.4426950408889634f;
constexpr int LDS_BYTES = 2 * 256 * 72 * 2 + 1024;

__device__ const float kInvFreq[16] = {1.0f, 0.5623413324356079f, 0.3162277638912201f, 0.17782793939113617f, 0.10000000149011612f, 0.05623413249850273f, 0.03162277489900589f, 0.017782794311642647f, 0.009999999776482582f, 0.005623413249850273f, 0.003162277629598975f, 0.0017782794311642647f, 0.0010000000474974513f, 0.000562341301701963f, 0.0003162277571391314f, 0.00017782794020604342f};

struct Params {
  const float *x, *c; const int* pos; const float *w_ada, *b_ada, *norm_w, *w_in, *qln, *w_uq, *kvln, *w_ukv, *qhn, *khn, *w_out;
  float* out;
  float* ada; unsigned* counters; float* cosT; float* sinT;
  bf16_t *WinT, *WuqT, *WukvT, *WoutT, *H, *Qsb, *Ksb, *Vsb, *Gate, *CQ, *CKV; float* KR; bf16_t *Qm, *Km, *Vm, *Mixed;
};

DI unsigned pk_bf16(float lo, float hi) { f32x2 v = {lo, hi}; bf2_t b = __builtin_convertvector(v, bf2_t); return __builtin_bit_cast(unsigned, b); }
DI bf16_t to_bf16(float x) { return (bf16_t)(pk_bf16(x, 0.f) & 0xffffu); }
DI float bf_lo(unsigned u) { return __uint_as_float(u << 16); }
DI float bf_hi(unsigned u) { return __uint_as_float(u & 0xffff0000u); }
DI int crow(int i, int h) { return (i & 3) + 8 * (i >> 2) + 4 * h; }
DI float fast_exp2(float x) { return __builtin_amdgcn_exp2f(x); }
DI float fast_log2(float x) { return __builtin_amdgcn_logf(x); }
DI float silu_f(float v) { return v * __builtin_amdgcn_rcpf(1.f + fast_exp2(-v * LOG2E)); }

DI void transpose_tile(const float* __restrict__ W, bf16_t* __restrict__ out, int K, int N, int k0, int n0, const float* __restrict__ scale, float* tile) {
  const int tid = threadIdx.x;
#pragma unroll 4
  for (int i = 0; i < 16; ++i) {
    const int kk = i * 4 + (tid >> 6), nn = tid & 63, n = n0 + nn;
    float v = (n < N) ? W[(size_t)(k0 + kk) * N + n] : 0.f;
    if (scale) v *= scale[k0 + kk];
    tile[kk * 65 + nn] = v;
  }
  __syncthreads();
#pragma unroll 4
  for (int i = 0; i < 16; ++i) {
    const int nn = i * 4 + (tid >> 6), kk = tid & 63;
    out[(size_t)(n0 + nn) * K + k0 + kk] = to_bf16(tile[kk * 65 + nn]);
  }
  __syncthreads();
}

DI void ada_item(const Params& p, float* red, int item) {
  const int tid = threadIdx.x, col = tid & 15, ks = tid >> 4, n = item * 16 + col;
  float a0 = 0.f, a1 = 0.f;
#pragma unroll 8
  for (int k = ks * 64; k < ks * 64 + 64; ++k) {
    const float w = p.w_ada[(size_t)k * 3072 + n];
    const float c0 = p.c[k], c1 = p.c[1024 + k];
    a0 += (c0 / (1.f + __expf(-c0))) * w;
    a1 += (c1 / (1.f + __expf(-c1))) * w;
  }
  red[(ks * 16 + col) * 2 + 0] = a0;
  red[(ks * 16 + col) * 2 + 1] = a1;
  __syncthreads();
  if (tid < 32) {
    const int cc = tid & 15, b = tid >> 4;
    float s = 0.f;
    for (int q = 0; q < 16; ++q) s += red[(q * 16 + cc) * 2 + b];
    p.ada[b * 3072 + item * 16 + cc] = s + p.b_ada[item * 16 + cc];
  }
  __syncthreads();
}

DI void rope_item(const Params& p, int item) {
  const int idx = item * 256 + threadIdx.x, token = idx >> 4, j = idx & 15;
  const float ang = (float)p.pos[token] * kInvFreq[j];
  const double a = (double)ang;
  const double n = rint(a * 0.6366197723675814);
  double r = fma(-n, 1.5707963267948966, a);
  r = fma(-n, 6.123233995736766e-17, r);
  const int q = ((int)n) & 3;
  const double r2 = r * r;
  const double sn = r * (1.0 + r2 * (-1.0 / 6 + r2 * (1.0 / 120 + r2 * (-1.0 / 5040 + r2 * (1.0 / 362880 + r2 * (-1.0 / 39916800))))));
  const double cs = 1.0 + r2 * (-0.5 + r2 * (1.0 / 24 + r2 * (-1.0 / 720 + r2 * (1.0 / 40320 + r2 * (-1.0 / 3628800 + r2 * (1.0 / 479001600))))));
  double co, si;
  if (q == 0) { co = cs; si = sn; } else if (q == 1) { co = -sn; si = cs; } else if (q == 2) { co = -cs; si = -sn; } else { co = sn; si = -cs; }
  p.cosT[idx] = (float)co;
  p.sinT[idx] = (float)si;
}

DI void phase0(const Params& p, char* smem, int bid, int nb) {
  constexpr int N_ADA = 192, N_TIN = 16 * 52, N_TUQ = 6 * 12, N_TUKV = 4 * 16, N_TOUT = 16 * 16, N_ROPE = 1024;
  constexpr int TOTAL = N_ADA + N_TIN + N_TUQ + N_TUKV + N_TOUT + N_ROPE;
  float* tile = (float*)smem;
  for (int it = bid; it < TOTAL; it += nb) {
    int i = it;
    if (i < N_ADA) { ada_item(p, tile, i); continue; }
    i -= N_ADA;
    if (i < N_TIN) { transpose_tile(p.w_in, p.WinT, 1024, INC, (i / 52) * 64, (i % 52) * 64, nullptr, tile); continue; }
    i -= N_TIN;
    if (i < N_TUQ) { transpose_tile(p.w_uq, p.WuqT, 384, 768, (i / 12) * 64, (i % 12) * 64, p.qln, tile); continue; }
    i -= N_TUQ;
    if (i < N_TUKV) { transpose_tile(p.w_ukv, p.WukvT, 256, 1024, (i / 16) * 64, (i % 16) * 64, p.kvln, tile); continue; }
    i -= N_TUKV;
    if (i < N_TOUT) { transpose_tile(p.w_out, p.WoutT, 1024, 1024, (i / 16) * 64, (i % 16) * 64, nullptr, tile); continue; }
    i -= N_TOUT;
    rope_item(p, i);
  }
  if (bid == 0 && threadIdx.x < 8) p.counters[threadIdx.x] = 0u;
}

DI void phase1(const Params& p, int bid, int nb) {
  const int tid = threadIdx.x, lane = tid & 63, wave = tid >> 6;
  for (int it = bid; it < NTOK / 4; it += nb) {
    const int row = it * 4 + wave, b = row >> 13;
    const f32x4* xr = (const f32x4*)(p.x + (size_t)row * DM);
    f32x4 v[4];
    float ss = 0.f;
#pragma unroll
    for (int i = 0; i < 4; ++i) { v[i] = xr[lane + 64 * i]; ss += v[i][0] * v[i][0] + v[i][1] * v[i][1] + v[i][2] * v[i][2] + v[i][3] * v[i][3]; }
#pragma unroll
    for (int o = 1; o < 64; o <<= 1) ss += __shfl_xor(ss, o);
    const float rstd = rsqrtf(ss * (1.f / DM) + 1e-6f);
    const float* ad = p.ada + b * 3072;
#pragma unroll
    for (int i = 0; i < 4; ++i) {
      const int k = (lane + 64 * i) * 4;
      const f32x4 nw = *(const f32x4*)(p.norm_w + k), sh = *(const f32x4*)(ad + k), sc = *(const f32x4*)(ad + 1024 + k);
      float o[4];
#pragma unroll
      for (int e = 0; e < 4; ++e) o[e] = (v[i][e] * rstd) * nw[e] * (1.f + sc[e]) + sh[e];
      u32x2 w; w.x = pk_bf16(o[0], o[1]); w.y = pk_bf16(o[2], o[3]);
      *(u32x2*)(p.H + (size_t)row * DM + k) = w;
    }
  }
}

template <int RM, int CN, int WR, int WC, bool SUMSQ>
DI void gemm_tile(const bf16_t* __restrict__ Rg, int ldr, const bf16_t* __restrict__ Cg, int ldc, int K, char* smem,
                  f32x16 (&acc)[RM / WR / 32][CN / WC / 32], float* sumsq) {
  constexpr int MI = RM / WR / 32, NI = CN / WC / 32, STR = 72, RCH = RM / 32, CCH = CN / 32, BUFE = (RM + CN) * STR;
  bf16_t* lds = (bf16_t*)smem;
  const int tid = threadIdx.x, lane = tid & 63, wave = tid >> 6, r = lane & 31, h = lane >> 5;
  const int wr = wave / WC, wc = wave % WC;
  const int srow = tid >> 3, skc = (tid & 7) * 8;
  u32x4 rr[RCH], cr[CCH];
  float ss[CCH];
#pragma unroll
  for (int i = 0; i < CCH; ++i) ss[i] = 0.f;
#pragma unroll
  for (int mi = 0; mi < MI; ++mi)
#pragma unroll
    for (int ni = 0; ni < NI; ++ni)
#pragma unroll
      for (int i = 0; i < 16; ++i) acc[mi][ni][i] = 0.f;
  const bf16_t* rp = Rg + (size_t)srow * ldr + skc;
  const bf16_t* cp = Cg + (size_t)srow * ldc + skc;
  const int nk = K / 64;
#pragma unroll
  for (int i = 0; i < RCH; ++i) rr[i] = *(const u32x4*)(rp + (size_t)(32 * i) * ldr);
#pragma unroll
  for (int i = 0; i < CCH; ++i) cr[i] = *(const u32x4*)(cp + (size_t)(32 * i) * ldc);
  for (int kt = 0; kt < nk; ++kt) {
    bf16_t* cur = lds + (kt & 1) * BUFE;
#pragma unroll
    for (int i = 0; i < RCH; ++i) *(u32x4*)(cur + (srow + 32 * i) * STR + skc) = rr[i];
#pragma unroll
    for (int i = 0; i < CCH; ++i) {
      *(u32x4*)(cur + (RM + srow + 32 * i) * STR + skc) = cr[i];
      if (SUMSQ) {
#pragma unroll
        for (int e = 0; e < 4; ++e) { const float a = bf_lo(cr[i][e]), b = bf_hi(cr[i][e]); ss[i] += a * a + b * b; }
      }
    }
    __syncthreads();
    if (kt + 1 < nk) {
      const int k0 = (kt + 1) * 64;
#pragma unroll
      for (int i = 0; i < RCH; ++i) rr[i] = *(const u32x4*)(rp + (size_t)(32 * i) * ldr + k0);
#pragma unroll
      for (int i = 0; i < CCH; ++i) cr[i] = *(const u32x4*)(cp + (size_t)(32 * i) * ldc + k0);
    }
    const bf16_t* abase = cur + (wr * (RM / WR) + r) * STR + h * 8;
    const bf16_t* bbase = cur + (RM + wc * (CN / WC) + r) * STR + h * 8;
#pragma unroll
    for (int ks = 0; ks < 4; ++ks) {
      bf16x8 a[MI], b[NI];
#pragma unroll
      for (int mi = 0; mi < MI; ++mi) a[mi] = *(const bf16x8*)(abase + mi * 32 * STR + ks * 16);
#pragma unroll
      for (int ni = 0; ni < NI; ++ni) b[ni] = *(const bf16x8*)(bbase + ni * 32 * STR + ks * 16);
#pragma unroll
      for (int mi = 0; mi < MI; ++mi)
#pragma unroll
        for (int ni = 0; ni < NI; ++ni) acc[mi][ni] = MFMA32(a[mi], b[ni], acc[mi][ni]);
    }
  }
  if (SUMSQ) {
#pragma unroll
    for (int i = 0; i < CCH; ++i) {
      float s = ss[i];
      s += __shfl_xor(s, 1); s += __shfl_xor(s, 2); s += __shfl_xor(s, 4);
      if ((tid & 7) == 0) sumsq[srow + 32 * i] = s;
    }
  }
  __syncthreads();
}

DI void phase2(const Params& p, char* smem, int bid, int nb) {
  const int tid = threadIdx.x, lane = tid & 63, wave = tid >> 6, r = lane & 31, h = lane >> 5, wr = wave >> 1, wc = wave & 1;
  for (int t = bid; t < 128 * 26; t += nb) {
    const int mt = t / 26, nt = t % 26, m0 = mt * 128, n0 = nt * 128;
    f32x16 acc[2][2];
    gemm_tile<128, 128, 2, 2, false>(p.H + (size_t)m0 * DM, DM, p.WinT + (size_t)n0 * DM, DM, DM, smem, acc, nullptr);
    const int b = m0 >> 13;
#pragma unroll
    for (int ni = 0; ni < 2; ++ni) {
      const int colg = n0 + wc * 64 + ni * 32;
      if (colg >= INC) continue;
#pragma unroll
      for (int mi = 0; mi < 2; ++mi) {
#pragma unroll
        for (int i = 0; i < 16; ++i) {
          const int token = m0 + wr * 64 + mi * 32 + crow(i, h);
          const int s = token & (S_ - 1);
          const float v = acc[mi][ni][i];
          if (colg < 1536) {
            const int which = colg >> 9, hh = (colg & 511) >> 6, d0 = colg & 63;
            bf16_t* dst = (which == 0 ? p.Qsb : (which == 1 ? p.Ksb : p.Vsb)) + ((size_t)(b * 8 + hh) * S_ + s) * 64 + d0 + r;
            *dst = to_bf16(which == 0 ? v * (0.125f * LOG2E) : v);
          } else if (colg < 2048) {
            p.Gate[(size_t)token * 1024 + (colg - 1536) + r] = to_bf16(silu_f(v));
          } else if (colg < 2432) {
            p.CQ[(size_t)token * 384 + (colg - 2048) + r] = to_bf16(v);
          } else if (colg < 2688) {
            p.CKV[(size_t)token * 256 + (colg - 2432) + r] = to_bf16(v);
          } else if (colg < 2720) {
            p.KR[(size_t)token * 32 + r] = v;
          } else {
            p.Gate[(size_t)token * 1024 + 512 + (colg - 2720) + r] = to_bf16(silu_f(v));
          }
        }
      }
    }
  }
}

DI void phase3(const Params& p, char* smem, int bid, int nb) {
  const int tid = threadIdx.x, lane = tid & 63, wave = tid >> 6, r = lane & 31, h = lane >> 5;
  float* sumsq = (float*)(smem + 2 * 256 * 72 * 2);
  for (int t = bid; t < 128 * 16; t += nb) {
    const int mt = t >> 4, sub = t & 15, head = sub & 7, m0 = mt * 128;
    const int tl = wave * 32 + r, token = m0 + tl, b = token >> 13, s = token & (S_ - 1);
    if (sub < 8) {
      f32x16 acc[3][1];
      gemm_tile<96, 128, 1, 4, true>(p.WuqT + (size_t)head * 96 * 384, 384, p.CQ + (size_t)m0 * 384, 384, 384, smem, acc, sumsq);
      const float rstd = rsqrtf(sumsq[tl] * (1.f / 384) + 1e-6f);
      float ssq = 0.f;
#pragma unroll
      for (int rb = 0; rb < 3; ++rb)
#pragma unroll
        for (int i = 0; i < 16; ++i) { const float v = acc[rb][0][i] * rstd; acc[rb][0][i] = v; ssq += v * v; }
      ssq += __shfl_xor(ssq, 32);
      const float r2 = rsqrtf(ssq * (1.f / 96) + 1e-6f);
#pragma unroll
      for (int rb = 0; rb < 3; ++rb)
#pragma unroll
        for (int g = 0; g < 4; ++g) {
          const f32x4 w4 = *(const f32x4*)(p.qhn + rb * 32 + 8 * g + 4 * h);
#pragma unroll
          for (int e = 0; e < 4; ++e) acc[rb][0][4 * g + e] *= r2 * w4[e];
        }
#pragma unroll
      for (int g = 0; g < 2; ++g) {
        const f32x4 c4 = *(const f32x4*)(p.cosT + (size_t)token * 16 + 8 * g + 4 * h), s4 = *(const f32x4*)(p.sinT + (size_t)token * 16 + 8 * g + 4 * h);
#pragma unroll
        for (int e = 0; e < 4; ++e) {
          const float x1 = acc[2][0][4 * g + e], x2 = acc[2][0][4 * (g + 2) + e];
          acc[2][0][4 * g + e] = x1 * c4[e] - x2 * s4[e];
          acc[2][0][4 * (g + 2) + e] = x2 * c4[e] + x1 * s4[e];
        }
      }
      const float qs = LOG2E * 0.10206207261596577f;
      bf16_t* dst = p.Qm + ((size_t)(b * 8 + head) * S_ + s) * 96;
#pragma unroll
      for (int rb = 0; rb < 3; ++rb)
#pragma unroll
        for (int g = 0; g < 4; ++g) {
          u32x2 w; w.x = pk_bf16(acc[rb][0][4 * g] * qs, acc[rb][0][4 * g + 1] * qs); w.y = pk_bf16(acc[rb][0][4 * g + 2] * qs, acc[rb][0][4 * g + 3] * qs);
          *(u32x2*)(dst + rb * 32 + 8 * g + 4 * h) = w;
        }
    } else {
      f32x16 acc[4][1];
      gemm_tile<128, 128, 1, 4, true>(p.WukvT + (size_t)head * 128 * 256, 256, p.CKV + (size_t)m0 * 256, 256, 256, smem, acc, sumsq);
      const float rstd = rsqrtf(sumsq[tl] * (1.f / 256) + 1e-6f);
      float kr[16];
#pragma unroll
      for (int g = 0; g < 4; ++g) {
        const f32x4 k4 = *(const f32x4*)(p.KR + (size_t)token * 32 + 8 * g + 4 * h);
#pragma unroll
        for (int e = 0; e < 4; ++e) kr[4 * g + e] = k4[e];
      }
      float ssq = 0.f;
#pragma unroll
      for (int rb = 0; rb < 2; ++rb)
#pragma unroll
        for (int i = 0; i < 16; ++i) { const float v = acc[rb][0][i] * rstd; acc[rb][0][i] = v; ssq += v * v; }
#pragma unroll
      for (int i = 0; i < 16; ++i) ssq += kr[i] * kr[i];
      ssq += __shfl_xor(ssq, 32);
      const float r2 = rsqrtf(ssq * (1.f / 96) + 1e-6f);
#pragma unroll
      for (int rb = 0; rb < 2; ++rb)
#pragma unroll
        for (int g = 0; g < 4; ++g) {
          const f32x4 w4 = *(const f32x4*)(p.khn + rb * 32 + 8 * g + 4 * h);
#pragma unroll
          for (int e = 0; e < 4; ++e) acc[rb][0][4 * g + e] *= r2 * w4[e];
        }
#pragma unroll
      for (int g = 0; g < 4; ++g) {
        const f32x4 w4 = *(const f32x4*)(p.khn + 64 + 8 * g + 4 * h);
#pragma unroll
        for (int e = 0; e < 4; ++e) kr[4 * g + e] *= r2 * w4[e];
      }
#pragma unroll
      for (int g = 0; g < 2; ++g) {
        const f32x4 c4 = *(const f32x4*)(p.cosT + (size_t)token * 16 + 8 * g + 4 * h), s4 = *(const f32x4*)(p.sinT + (size_t)token * 16 + 8 * g + 4 * h);
#pragma unroll
        for (int e = 0; e < 4; ++e) {
          const float x1 = kr[4 * g + e], x2 = kr[4 * (g + 2) + e];
          kr[4 * g + e] = x1 * c4[e] - x2 * s4[e];
          kr[4 * (g + 2) + e] = x2 * c4[e] + x1 * s4[e];
        }
      }
      bf16_t* dk = p.Km + ((size_t)(b * 8 + head) * S_ + s) * 96;
      bf16_t* dv = p.Vm + ((size_t)(b * 8 + head) * S_ + s) * 64;
#pragma unroll
      for (int rb = 0; rb < 2; ++rb)
#pragma unroll
        for (int g = 0; g < 4; ++g) {
          u32x2 w; w.x = pk_bf16(acc[rb][0][4 * g], acc[rb][0][4 * g + 1]); w.y = pk_bf16(acc[rb][0][4 * g + 2], acc[rb][0][4 * g + 3]);
          *(u32x2*)(dk + rb * 32 + 8 * g + 4 * h) = w;
          u32x2 u; u.x = pk_bf16(acc[rb + 2][0][4 * g] * rstd, acc[rb + 2][0][4 * g + 1] * rstd); u.y = pk_bf16(acc[rb + 2][0][4 * g + 2] * rstd, acc[rb + 2][0][4 * g + 3] * rstd);
          *(u32x2*)(dv + rb * 32 + 8 * g + 4 * h) = u;
        }
#pragma unroll
      for (int g = 0; g < 4; ++g) {
        u32x2 w; w.x = pk_bf16(kr[4 * g], kr[4 * g + 1]); w.y = pk_bf16(kr[4 * g + 2], kr[4 * g + 3]);
        *(u32x2*)(dk + 64 + 8 * g + 4 * h) = w;
      }
    }
  }
}

template <int DQK, bool SB>
DI void attn_item(const Params& p, char* smem, int bh, int qb) {
  constexpr int KSTR = DQK + 8, VSTR = 72, NKS = DQK / 16, KCH = DQK / 8, KPT = 64 * KCH / 256, KBUF = 64 * KSTR, VBUF = 64 * VSTR;
  bf16_t* Ks = (bf16_t*)smem;
  bf16_t* Vs = Ks + 2 * KBUF;
  int* flags = (int*)(Vs + 2 * VBUF);
  const bf16_t* Qg = SB ? p.Qsb : p.Qm;
  const bf16_t* Kg = (SB ? p.Ksb : p.Km) + (size_t)bh * S_ * DQK;
  const bf16_t* Vg = (SB ? p.Vsb : p.Vm) + (size_t)bh * S_ * 64;
  const int tid = threadIdx.x, lane = tid & 63, wave = tid >> 6, r = lane & 31, h = lane >> 5;
  const int q0 = qb * 128, qw0 = q0 + wave * 32, query = qw0 + r;
  bf16x8 qf[NKS];
  {
    const bf16_t* qp = Qg + ((size_t)bh * S_ + query) * DQK + h * 8;
#pragma unroll
    for (int ks = 0; ks < NKS; ++ks) qf[ks] = *(const bf16x8*)(qp + ks * 16);
  }
  bf16x8 tri[2], ones;
#pragma unroll
  for (int s = 0; s < 2; ++s)
#pragma unroll
    for (int j = 0; j < 8; ++j) tri[s][j] = ((16 * s + 8 * (j >> 2) + 4 * h + (j & 3)) >= r) ? (short)0x3F80 : (short)0;
#pragma unroll
  for (int j = 0; j < 8; ++j) ones[j] = (short)0x3F80;

  const int nt = 2 * (qb + 1);
  f32x16 O[2];
#pragma unroll
  for (int db = 0; db < 2; ++db)
#pragma unroll
    for (int i = 0; i < 16; ++i) O[db][i] = 0.f;
  float m = -__builtin_huge_valf(), lsum = 0.f, carry = 0.f;

  u32x4 kreg[KPT], vreg[2];
  {
    const int kb0 = SB ? 64 * (nt - 1) : 0;
#pragma unroll
    for (int i = 0; i < KPT; ++i) kreg[i] = *(const u32x4*)(Kg + (size_t)kb0 * DQK + (tid + 256 * i) * 8);
#pragma unroll
    for (int i = 0; i < 2; ++i) vreg[i] = *(const u32x4*)(Vg + (size_t)kb0 * 64 + (tid + 256 * i) * 8);
  }
  const int blk = (lane >> 4) & 1, tq = (lane & 15) >> 2, tp = lane & 3;
  const int voff = (4 * h + tq) * VSTR + 16 * blk + 4 * tp;

  for (int it = 0; it < nt; ++it) {
    const int kb0 = SB ? 64 * (nt - 1 - it) : 64 * it;
    bf16_t* kc = Ks + (it & 1) * KBUF;
    bf16_t* vc = Vs + (it & 1) * VBUF;
#pragma unroll
    for (int i = 0; i < KPT; ++i) { const int c = tid + 256 * i, row = c / KCH, kcol = c % KCH; *(u32x4*)(kc + row * KSTR + kcol * 8) = kreg[i]; }
#pragma unroll
    for (int i = 0; i < 2; ++i) { const int c = tid + 256 * i; *(u32x4*)(vc + (c >> 3) * VSTR + (c & 7) * 8) = vreg[i]; }
    __syncthreads();
    if (it + 1 < nt) {
      const int kn0 = SB ? kb0 - 64 : kb0 + 64;
#pragma unroll
      for (int i = 0; i < KPT; ++i) kreg[i] = *(const u32x4*)(Kg + (size_t)kn0 * DQK + (tid + 256 * i) * 8);
#pragma unroll
      for (int i = 0; i < 2; ++i) vreg[i] = *(const u32x4*)(Vg + (size_t)kn0 * 64 + (tid + 256 * i) * 8);
    }
    if (kb0 < qw0 + 32) {
      f32x16 st[2];
#pragma unroll
      for (int kb = 0; kb < 2; ++kb)
#pragma unroll
        for (int i = 0; i < 16; ++i) st[kb][i] = 0.f;
#pragma unroll
      for (int ks = 0; ks < NKS; ++ks)
#pragma unroll
        for (int kb = 0; kb < 2; ++kb) {
          const bf16x8 a = *(const bf16x8*)(kc + (kb * 32 + r) * KSTR + ks * 16 + h * 8);
          st[kb] = MFMA32(a, qf[ks], st[kb]);
        }
      const bool diag = (kb0 + 64 > qw0);
      bf16x8 pk[4];
      if (!SB) {
        if (diag) {
#pragma unroll
          for (int kb = 0; kb < 2; ++kb)
#pragma unroll
            for (int i = 0; i < 16; ++i) { const int key = kb0 + kb * 32 + crow(i, h); if (key > query) st[kb][i] = -__builtin_huge_valf(); }
        }
        float mx = st[0][0];
#pragma unroll
        for (int kb = 0; kb < 2; ++kb)
#pragma unroll
          for (int i = 0; i < 16; ++i) mx = fmaxf(mx, st[kb][i]);
        mx = fmaxf(mx, __shfl_xor(mx, 32));
        const float mnew = fmaxf(m, mx);
        const float alpha = fast_exp2(m - mnew);
        m = mnew;
        float ps = 0.f;
#pragma unroll
        for (int kb = 0; kb < 2; ++kb)
#pragma unroll
          for (int i = 0; i < 16; ++i) { const float pv = fast_exp2(st[kb][i] - mnew); st[kb][i] = pv; ps += pv; }
        lsum = lsum * alpha + ps;
#pragma unroll
        for (int db = 0; db < 2; ++db)
#pragma unroll
          for (int i = 0; i < 16; ++i) O[db][i] *= alpha;
      } else {
        f32x16 ca[2];
        bf16x8 hi[4], lo[4];
        float tsum = 0.f;
#pragma unroll
        for (int kb = 0; kb < 2; ++kb)
#pragma unroll
          for (int i2 = 0; i2 < 8; ++i2) {
            float lk[2];
#pragma unroll
            for (int e = 0; e < 2; ++e) {
              const int i = 2 * i2 + e;
              const float z = fminf(st[kb][i], 100.f);
              const int key = kb0 + kb * 32 + crow(i, h);
              const bool valid = !diag || (key < query);
              float l = -fast_log2(1.f + fast_exp2(z));
              l = valid ? l : 0.f;
              lk[e] = l;
              tsum += l;
              ca[kb][i] = z + carry;
            }
            const unsigned hp = pk_bf16(lk[0], lk[1]);
            const unsigned lp = pk_bf16(lk[0] - bf_lo(hp), lk[1] - bf_hi(hp));
            const int kk = kb * 2 + (i2 >> 2), w = i2 & 3;
            hi[kk][2 * w] = (short)(hp & 0xffffu); hi[kk][2 * w + 1] = (short)(hp >> 16);
            lo[kk][2 * w] = (short)(lp & 0xffffu); lo[kk][2 * w + 1] = (short)(lp >> 16);
          }
        tsum += __shfl_xor(tsum, 32);
#pragma unroll
        for (int s = 0; s < 2; ++s) {
          ca[0] = MFMA32(tri[s], hi[s], ca[0]);
          ca[0] = MFMA32(tri[s], lo[s], ca[0]);
          ca[0] = MFMA32(ones, hi[2 + s], ca[0]);
          ca[0] = MFMA32(ones, lo[2 + s], ca[0]);
          ca[1] = MFMA32(tri[s], hi[2 + s], ca[1]);
          ca[1] = MFMA32(tri[s], lo[2 + s], ca[1]);
        }
#pragma unroll
        for (int kb = 0; kb < 2; ++kb)
#pragma unroll
          for (int i = 0; i < 16; ++i) {
            const int key = kb0 + kb * 32 + crow(i, h);
            const bool valid = !diag || (key < query);
            st[kb][i] = valid ? fast_exp2(ca[kb][i]) : 0.f;
          }
        carry += tsum;
      }
#pragma unroll
      for (int kb = 0; kb < 2; ++kb)
#pragma unroll
        for (int s = 0; s < 2; ++s) {
          u32x4 w;
#pragma unroll
          for (int e = 0; e < 4; ++e) w[e] = pk_bf16(st[kb][8 * s + 2 * e], st[kb][8 * s + 2 * e + 1]);
          pk[kb * 2 + s] = __builtin_bit_cast(bf16x8, w);
        }
#pragma unroll
      for (int kk = 0; kk < 4; ++kk)
#pragma unroll
        for (int db = 0; db < 2; ++db) {
          const s16x4 v0 = __builtin_amdgcn_ds_read_tr16_b64_v4i16((lds_s16x4*)(vc + voff + (16 * kk) * VSTR + 32 * db));
          const s16x4 v1 = __builtin_amdgcn_ds_read_tr16_b64_v4i16((lds_s16x4*)(vc + voff + (16 * kk + 8) * VSTR + 32 * db));
          const bf16x8 vf = __builtin_shufflevector(v0, v1, 0, 1, 2, 3, 4, 5, 6, 7);
          O[db] = MFMA32(vf, pk[kk], O[db]);
        }
    }
    if (SB) {
      const bool alive = __builtin_amdgcn_ballot_w64(carry > -150.f) != 0ull;
      if (lane == 0) flags[(it & 1) * 4 + wave] = alive ? 1 : 0;
      __syncthreads();
      const int any = flags[(it & 1) * 4 + 0] | flags[(it & 1) * 4 + 1] | flags[(it & 1) * 4 + 2] | flags[(it & 1) * 4 + 3];
      if (!any) break;
    }
  }
  float inv = 1.f;
  if (!SB) { const float lt = lsum + __shfl_xor(lsum, 32); inv = 1.f / lt; }
  const size_t token = (size_t)(bh >> 3) * S_ + query;
  const int colbase = (SB ? 0 : 512) + (bh & 7) * 64;
#pragma unroll
  for (int db = 0; db < 2; ++db)
#pragma unroll
    for (int g = 0; g < 4; ++g) {
      const int col = colbase + db * 32 + 8 * g + 4 * h;
      const u32x2 gt = *(const u32x2*)(p.Gate + token * 1024 + col);
      u32x2 w;
      w.x = pk_bf16(O[db][4 * g] * inv * bf_lo(gt.x), O[db][4 * g + 1] * inv * bf_hi(gt.x));
      w.y = pk_bf16(O[db][4 * g + 2] * inv * bf_lo(gt.y), O[db][4 * g + 3] * inv * bf_hi(gt.y));
      *(u32x2*)(p.Mixed + token * 1024 + col) = w;
    }
  __syncthreads();
}

DI void phase4(const Params& p, char* smem) {
  int* s_item = (int*)(smem + LDS_BYTES - 16);
  for (;;) {
    if (threadIdx.x == 0) *s_item = (int)atomicAdd(&p.counters[0], 1u);
    __syncthreads();
    const int item = *s_item;
    __syncthreads();
    if (item >= 2048) break;
    if (item < 1024) attn_item<96, false>(p, smem, item & 15, 63 - (item >> 4));
    else { const int j = item - 1024; attn_item<64, true>(p, smem, j & 15, 63 - (j >> 4)); }
  }
}

DI void phase5(const Params& p, char* smem, int bid, int nb) {
  const int tid = threadIdx.x, lane = tid & 63, wave = tid >> 6, r = lane & 31, h = lane >> 5, wr = wave >> 1, wc = wave & 1;
  for (int t = bid; t < 128 * 8; t += nb) {
    const int mt = t >> 3, nt = t & 7, m0 = mt * 128, n0 = nt * 128;
    f32x16 acc[2][2];
    gemm_tile<128, 128, 2, 2, false>(p.Mixed + (size_t)m0 * DM, DM, p.WoutT + (size_t)n0 * DM, DM, DM, smem, acc, nullptr);
    const int b = m0 >> 13;
#pragma unroll
    for (int ni = 0; ni < 2; ++ni) {
      const int n = n0 + wc * 64 + ni * 32 + r;
      const float gt = p.ada[b * 3072 + 2048 + n];
#pragma unroll
      for (int mi = 0; mi < 2; ++mi)
#pragma unroll
        for (int i = 0; i < 16; ++i) {
          const size_t idx = (size_t)(m0 + wr * 64 + mi * 32 + crow(i, h)) * DM + n;
          p.out[idx] = p.x[idx] + gt * acc[mi][ni][i];
        }
    }
  }
}

template <int PH>
__global__ void __launch_bounds__(256, 2) k_phase(Params p) {
  __shared__ __attribute__((aligned(16))) char smem[LDS_BYTES];
  const int bid = blockIdx.x, nb = gridDim.x;
  if (PH == 0) phase0(p, smem, bid, nb);
  if (PH == 1) phase1(p, bid, nb);
  if (PH == 2) phase2(p, smem, bid, nb);
  if (PH == 3) phase3(p, smem, bid, nb);
  if (PH == 4) phase4(p, smem);
  if (PH == 5) phase5(p, smem, bid, nb);
}

__global__ void __launch_bounds__(256, 2) k_mega(Params p) {
  __shared__ __attribute__((aligned(16))) char smem[LDS_BYTES];
  cg::grid_group grid = cg::this_grid();
  const int bid = blockIdx.x, nb = gridDim.x;
  phase0(p, smem, bid, nb);
  grid.sync();
  phase1(p, bid, nb);
  grid.sync();
  phase2(p, smem, bid, nb);
  grid.sync();
  phase3(p, smem, bid, nb);
  grid.sync();
  phase4(p, smem);
  grid.sync();
  phase5(p, smem, bid, nb);
}

extern "C" void kernel_launch(void* const* d_in, const int* in_sizes, int n_in, void* d_out, int out_size, void* d_ws, size_t ws_size, hipStream_t stream) {
  Params p{};
  p.x = (const float*)d_in[0]; p.c = (const float*)d_in[1]; p.pos = (const int*)d_in[2];
  p.w_ada = (const float*)d_in[3]; p.b_ada = (const float*)d_in[4]; p.norm_w = (const float*)d_in[5]; p.w_in = (const float*)d_in[6];
  p.qln = (const float*)d_in[7]; p.w_uq = (const float*)d_in[8]; p.kvln = (const float*)d_in[9]; p.w_ukv = (const float*)d_in[10];
  p.qhn = (const float*)d_in[11]; p.khn = (const float*)d_in[12]; p.w_out = (const float*)d_in[13];
  p.out = (float*)d_out;
  char* w = (char*)d_ws;
  size_t off = 0;
  auto take = [&](size_t bytes) { char* q = w + off; off += (bytes + 255) & ~(size_t)255; return q; };
  p.ada = (float*)take(2 * 3072 * 4);
  p.counters = (unsigned*)take(256);
  p.cosT = (float*)take((size_t)NTOK * 16 * 4);
  p.sinT = (float*)take((size_t)NTOK * 16 * 4);
  p.WinT = (bf16_t*)take((size_t)INPAD * 1024 * 2);
  p.WuqT = (bf16_t*)take((size_t)768 * 384 * 2);
  p.WukvT = (bf16_t*)take((size_t)1024 * 256 * 2);
  p.WoutT = (bf16_t*)take((size_t)1024 * 1024 * 2);
  p.H = (bf16_t*)take((size_t)NTOK * 1024 * 2);
  p.Qsb = (bf16_t*)take((size_t)NTOK * 512 * 2);
  p.Ksb = (bf16_t*)take((size_t)NTOK * 512 * 2);
  p.Vsb = (bf16_t*)take((size_t)NTOK * 512 * 2);
  p.Gate = (bf16_t*)take((size_t)NTOK * 1024 * 2);
  p.CQ = (bf16_t*)take((size_t)NTOK * 384 * 2);
  p.CKV = (bf16_t*)take((size_t)NTOK * 256 * 2);
  p.KR = (float*)take((size_t)NTOK * 32 * 4);
  p.Qm = (bf16_t*)take((size_t)NTOK * 768 * 2);
  p.Km = (bf16_t*)take((size_t)NTOK * 768 * 2);
  p.Vm = (bf16_t*)take((size_t)NTOK * 512 * 2);
  p.Mixed = p.H;
#if ONE_LAUNCH
  static int grid_blocks = 0;
  if (!grid_blocks) {
    int dev = 0, cus = 0, per_cu = 0;
    hipGetDevice(&dev);
    hipDeviceGetAttribute(&cus, hipDeviceAttributeMultiprocessorCount, dev);
    hipOccupancyMaxActiveBlocksPerMultiprocessor(&per_cu, k_mega, 256, 0);
    if (per_cu > 2) per_cu = 2;
    grid_blocks = cus * per_cu;
  }
  void* args[] = {&p};
  hipError_t e = hipLaunchCooperativeKernel((void*)k_mega, dim3(grid_blocks), dim3(256), args, 0, stream);
  if (e != hipSuccess) fprintf(stderr, "cooperative launch failed: %s (grid %d)\n", hipGetErrorString(e), grid_blocks);
#else
  const int G = 512;
  k_phase<0><<<G, 256, 0, stream>>>(p);
  k_phase<1><<<G, 256, 0, stream>>>(p);
  k_phase<2><<<G, 256, 0, stream>>>(p);
  k_phase<3><<<G, 256, 0, stream>>>(p);
  k_phase<4><<<G, 256, 0, stream>>>(p);
  k_phase<5><<<G, 256, 0, stream>>>(p);
#endif
}
```

```cpp
#include <hip/hip_runtime.h>
#include <hip/hip_cooperative_groups.h>
#include <cstdio>
#include <cstdint>
namespace cg = cooperative_groups;

#ifndef ONE_LAUNCH
#define ONE_LAUNCH 1
#endif

typedef unsigned short bf16_t;
typedef short bf16x8 __attribute__((ext_vector_type(8)));
typedef short s16x4 __attribute__((ext_vector_type(4)));
typedef float f32x16 __attribute__((ext_vector_type(16)));
typedef float f32x4 __attribute__((ext_vector_type(4)));
typedef float f32x2 __attribute__((ext_vector_type(2)));
typedef __bf16 bf2_t __attribute__((ext_vector_type(2)));
typedef unsigned u32x4 __attribute__((ext_vector_type(4)));
typedef unsigned u32x2 __attribute__((ext_vector_type(2)));
typedef __attribute__((address_space(3))) s16x4 lds_s16x4;

#define DI __device__ __forceinline__
#define MFMA32(a, b, c) __builtin_amdgcn_mfma_f32_32x32x16_bf16((a), (b), (c), 0, 0, 0)

constexpr int S_ = 8192, NTOK = 16384, DM = 1024, INC = 3232, INPAD = 3328;
constexpr float LOG2E = 1.4426950408889634f;
constexpr int LDS_BYTES = 2 * 256 * 72 * 2 + 1536;

__device__ const float kInvFreq[16] = {1.0f, 0.5623413324356079f, 0.3162277638912201f, 0.17782793939113617f, 0.10000000149011612f, 0.05623413249850273f, 0.03162277489900589f, 0.017782794311642647f, 0.009999999776482582f, 0.005623413249850273f, 0.003162277629598975f, 0.0017782794311642647f, 0.0010000000474974513f, 0.000562341301701963f, 0.0003162277571391314f, 0.00017782794020604342f};

struct Params {
  const float *x, *c; const int* pos; const float *w_ada, *b_ada, *norm_w, *w_in, *qln, *w_uq, *kvln, *w_ukv, *qhn, *khn, *w_out;
  float* out;
  float* ada; unsigned* counters; float* cosT; float* sinT;
  bf16_t *WinT, *WuqT, *WukvT, *WoutT, *H, *Qsb, *Ksb, *Vsb, *Gate, *CQ, *CKV; float* KR; bf16_t *Qm, *Km, *Vm, *Mixed;
};

DI unsigned pk_bf16(float lo, float hi) { f32x2 v = {lo, hi}; bf2_t b = __builtin_convertvector(v, bf2_t); return __builtin_bit_cast(unsigned, b); }
DI bf16_t to_bf16(float x) { return (bf16_t)(pk_bf16(x, 0.f) & 0xffffu); }
DI float bf_lo(unsigned u) { return __uint_as_float(u << 16); }
DI float bf_hi(unsigned u) { return __uint_as_float(u & 0xffff0000u); }
DI int crow(int i, int h) { return (i & 3) + 8 * (i >> 2) + 4 * h; }
DI u32x4 widen_pair(u32x2 a, u32x2 b) {
  const auto rx = __builtin_amdgcn_permlane32_swap(a.x, b.x, false, false);
  const auto ry = __builtin_amdgcn_permlane32_swap(a.y, b.y, false, false);
  const u32x4 w = {rx[0], ry[0], rx[1], ry[1]};
  return w;
}
DI float fast_exp2(float x) { return __builtin_amdgcn_exp2f(x); }
DI float fast_log2(float x) { return __builtin_amdgcn_logf(x); }
DI float silu_f(float v) { return v * __builtin_amdgcn_rcpf(1.f + fast_exp2(-v * LOG2E)); }


#define XB_TMO      128
#define XB_XCNT(j)  (256  + 64 * (j))
#define XB_XSUB(j)  (1280 + 64 * (j))
#define XB_XGEN(j)  (2304 + 64 * (j))
#define XB_TOP      3328
#define XB_TOPGEN   3392
#define XCD_BAR_WORDS 3456
#define XB_WQ(v)    (3520 + 64 * (v))
#define XB_LSUB(j)  (4096 + 64 * (j))
#define XB_LGEN(j)  (5120 + 64 * (j))
#define XB_TOTAL_WORDS 6144
#define XB_SPIN_CAP (1u << 22)
#define LAS __attribute__((address_space(3)))
DI unsigned xb_ld(unsigned* p) { return __hip_atomic_load(p, __ATOMIC_RELAXED, __HIP_MEMORY_SCOPE_AGENT); }
DI unsigned xb_add(unsigned* p, unsigned v) { return __hip_atomic_fetch_add(p, v, __ATOMIC_RELAXED, __HIP_MEMORY_SCOPE_AGENT); }
DI unsigned xb_xcc_id() { return (unsigned)__builtin_amdgcn_s_getreg((3 << 11) | 20) & 0xFu; }
#define XB_SPIN(cond, bar) do { unsigned _sp = 0; while (cond) { __builtin_amdgcn_s_sleep(1); \
    if ((++_sp & 255u) == 0u) { if (xb_ld(&(bar)[XB_TMO])) break; if (_sp > XB_SPIN_CAP) { atomicAdd(&(bar)[XB_TMO], 1u); break; } } } } while (0)
struct XcdBarrier { unsigned* bar; unsigned x; volatile LAS unsigned* st; };
DI XcdBarrier xcd_barrier_post(unsigned* bar, volatile LAS unsigned* st) {
  XcdBarrier b; b.bar = bar; b.x = xb_xcc_id(); b.st = st;
  if (threadIdx.x == 0) st[2] = xb_add(&bar[XB_XCNT(b.x)], 1u);
  return b;
}
DI void xcd_barrier_complete(unsigned* bar, unsigned x, unsigned& nloc, unsigned& nx, unsigned& xi) {
  const unsigned G = gridDim.x * gridDim.y * gridDim.z;
  unsigned sum, cnt, mine, below, sp = 0u;
  for (;;) {
    sum = 0u; cnt = 0u; mine = 0u; below = 0u;
#pragma unroll
    for (unsigned j = 0; j < 16; ++j) { const unsigned c = xb_ld(&bar[XB_XCNT(j)]); sum += c; cnt += (c > 0u) ? 1u : 0u; mine = (j == x) ? c : mine; below += (j < x && c > 0u) ? 1u : 0u; }
    if (sum == G) break;
    __builtin_amdgcn_s_sleep(1);
    if ((++sp & 255u) == 0u) { if (xb_ld(&bar[XB_TMO])) break; if (sp > XB_SPIN_CAP) { atomicAdd(&bar[XB_TMO], 1u); break; } }
  }
  nloc = mine > 0u ? mine : 1u; nx = cnt > 0u ? cnt : 1u; xi = below;
}
DI void xcd_census(const XcdBarrier& b) {
  if (threadIdx.x == 0) { unsigned nloc, nx, xi; xcd_barrier_complete(b.bar, b.x, nloc, nx, xi); b.st[0] = nloc; b.st[1] = nx; b.st[3] = xi; }
}
DI void xcd_barrier(const XcdBarrier& b) {
  asm volatile("s_waitcnt vmcnt(0)" ::: "memory");
  __syncthreads();
  if (threadIdx.x == 0) {
    unsigned* bar = b.bar;
    __builtin_amdgcn_s_waitcnt(0);
    const unsigned nloc = b.st[0], nx = b.st[1];
    const unsigned old = xb_add(&bar[XB_XSUB(b.x)], 1u);
    const unsigned gen = old / nloc;
    if (old + 1u == (gen + 1u) * nloc) {
      __builtin_amdgcn_fence(__ATOMIC_RELEASE, "agent");
      asm volatile("s_waitcnt vmcnt(0)" ::: "memory");
      const unsigned og = xb_add(&bar[XB_TOP], 1u);
      const unsigned tg = og / nx;
      if (og + 1u == (tg + 1u) * nx) xb_add(&bar[XB_TOPGEN], 1u);
      else XB_SPIN(xb_ld(&bar[XB_TOPGEN]) == tg, bar);
      __builtin_amdgcn_fence(__ATOMIC_ACQUIRE, "agent");
      xb_add(&bar[XB_XGEN(b.x)], 1u);
      asm volatile("s_waitcnt vmcnt(0)" ::: "memory");
    } else {
      XB_SPIN(xb_ld(&bar[XB_XGEN(b.x)]) == gen, bar);
      __builtin_amdgcn_fence(__ATOMIC_ACQUIRE, "agent");
      asm volatile("s_waitcnt vmcnt(0)" ::: "memory");
    }
  }
  __syncthreads();
}

DI void xcd_local_barrier(const XcdBarrier& b) {
  asm volatile("s_waitcnt vmcnt(0)" ::: "memory");
  __syncthreads();
  if (threadIdx.x == 0) {
    unsigned* bar = b.bar;
    __builtin_amdgcn_s_waitcnt(0);
    const unsigned nloc = b.st[0];
    const unsigned old = xb_add(&bar[XB_LSUB(b.x)], 1u);
    const unsigned gen = old / nloc;
    if (old + 1u == (gen + 1u) * nloc) xb_add(&bar[XB_LGEN(b.x)], 1u);
    else XB_SPIN(xb_ld(&bar[XB_LGEN(b.x)]) == gen, bar);
    __builtin_amdgcn_fence(__ATOMIC_ACQUIRE, "agent");
    asm volatile("s_waitcnt vmcnt(0)" ::: "memory");
  }
  __syncthreads();
}

struct Sched { int xi, nx, rank, nloc; };

DI void transpose_tile(const float* __restrict__ W, bf16_t* __restrict__ out, int K, int N, int k0, int n0, const float* __restrict__ scale, float* tile) {
  const int tid = threadIdx.x;
  float tv[16];
#pragma unroll
  for (int i = 0; i < 16; ++i) {
    const int kk = i * 4 + (tid >> 6), nn = tid & 63, n = n0 + nn;
    tv[i] = (n < N) ? W[(size_t)(k0 + kk) * N + n] : 0.f;
  }
#pragma unroll
  for (int i = 0; i < 16; ++i) {
    const int kk = i * 4 + (tid >> 6), nn = tid & 63;
    float v = tv[i];
    if (scale) v *= scale[k0 + kk];
    tile[kk * 65 + nn] = v;
  }
  __syncthreads();
#pragma unroll
  for (int i = 0; i < 2; ++i) {
    const int nn = i * 32 + (tid >> 3), kk8 = (tid & 7) * 8;
    u32x4 w;
#pragma unroll
    for (int e = 0; e < 4; ++e) w[e] = pk_bf16(tile[(kk8 + 2 * e) * 65 + nn], tile[(kk8 + 2 * e + 1) * 65 + nn]);
    *(u32x4*)(out + (size_t)(n0 + nn) * K + k0 + kk8) = w;
  }
  __syncthreads();
}

DI void ada_item(const Params& p, float* red, int item) {
  const int tid = threadIdx.x, col = tid & 15, ks = tid >> 4, n = item * 16 + col;
  float a0 = 0.f, a1 = 0.f;
#pragma unroll
  for (int kq = 0; kq < 2; ++kq) {
    float wv[32];
#pragma unroll
    for (int j = 0; j < 32; ++j) wv[j] = p.w_ada[(size_t)(ks * 64 + kq * 32 + j) * 3072 + n];
#pragma unroll
    for (int j = 0; j < 32; ++j) {
      const int k = ks * 64 + kq * 32 + j;
      const float c0 = p.c[k], c1 = p.c[1024 + k];
      a0 += (c0 / (1.f + __expf(-c0))) * wv[j];
      a1 += (c1 / (1.f + __expf(-c1))) * wv[j];
    }
  }
  red[(ks * 16 + col) * 2 + 0] = a0;
  red[(ks * 16 + col) * 2 + 1] = a1;
  __syncthreads();
  if (tid < 32) {
    const int cc = tid & 15, b = tid >> 4;
    float s = 0.f;
    for (int q = 0; q < 16; ++q) s += red[(q * 16 + cc) * 2 + b];
    p.ada[b * 3072 + item * 16 + cc] = s + p.b_ada[item * 16 + cc];
  }
  __syncthreads();
}

DI void rope_item(const Params& p, int item) {
  const int idx = item * 256 + threadIdx.x, token = idx >> 4, j = idx & 15;
  const float ang = (float)p.pos[token] * kInvFreq[j];
  const double a = (double)ang;
  const double n = rint(a * 0.6366197723675814);
  double r = fma(-n, 1.5707963267948966, a);
  r = fma(-n, 6.123233995736766e-17, r);
  const int q = ((int)n) & 3;
  const double r2 = r * r;
  const double sn = r * (1.0 + r2 * (-1.0 / 6 + r2 * (1.0 / 120 + r2 * (-1.0 / 5040 + r2 * (1.0 / 362880 + r2 * (-1.0 / 39916800))))));
  const double cs = 1.0 + r2 * (-0.5 + r2 * (1.0 / 24 + r2 * (-1.0 / 720 + r2 * (1.0 / 40320 + r2 * (-1.0 / 3628800 + r2 * (1.0 / 479001600))))));
  double co, si;
  if (q == 0) { co = cs; si = sn; } else if (q == 1) { co = -sn; si = cs; } else if (q == 2) { co = -cs; si = -sn; } else { co = sn; si = -cs; }
  p.cosT[idx] = (float)co;
  p.sinT[idx] = (float)si;
}

DI void phase0(const Params& p, char* smem, int bid, int nb) {
  constexpr int N_ADA = 192, N_TIN = 16 * 52, N_TUQ = 6 * 12, N_TUKV = 4 * 16, N_TOUT = 16 * 16, N_ROPE = 1024;
  constexpr int TOTAL = N_ADA + N_TIN + N_TUQ + N_TUKV + N_TOUT + N_ROPE;
  float* tile = (float*)smem;
  for (int it = bid; it < TOTAL; it += nb) {
    int i = it;
    if (i < N_ADA) { ada_item(p, tile, i); continue; }
    i -= N_ADA;
    if (i < N_TIN) { transpose_tile(p.w_in, p.WinT, 1024, INC, (i / 52) * 64, (i % 52) * 64, nullptr, tile); continue; }
    i -= N_TIN;
    if (i < N_TUQ) { transpose_tile(p.w_uq, p.WuqT, 384, 768, (i / 12) * 64, (i % 12) * 64, p.qln, tile); continue; }
    i -= N_TUQ;
    if (i < N_TUKV) { transpose_tile(p.w_ukv, p.WukvT, 256, 1024, (i / 16) * 64, (i % 16) * 64, p.kvln, tile); continue; }
    i -= N_TUKV;
    if (i < N_TOUT) { transpose_tile(p.w_out, p.WoutT, 1024, 1024, (i / 16) * 64, (i % 16) * 64, nullptr, tile); continue; }
    i -= N_TOUT;
    rope_item(p, i);
  }
}

DI void phase1(const Params& p, const Sched sc) {
  const int tid = threadIdx.x, lane = tid & 63, wave = tid >> 6;
  for (int v = sc.xi; v < 8; v += sc.nx)
  for (int l = sc.rank; l < 128; l += sc.nloc) {
    const int rowa = v * 2048 + l * 16 + wave * 4, b = rowa >> 13;
    f32x4 v4[4][4];
#pragma unroll
    for (int q = 0; q < 4; ++q) {
      const f32x4* xr = (const f32x4*)(p.x + (size_t)(rowa + q) * DM);
#pragma unroll
      for (int i = 0; i < 2; ++i) { v4[q][2 * i] = xr[2 * lane + 128 * i]; v4[q][2 * i + 1] = xr[2 * lane + 128 * i + 1]; }
    }
    const float* ad = p.ada + b * 3072;
    f32x4 nw[4], sh[4];
#pragma unroll
    for (int j = 0; j < 4; ++j) {
      const int k = (2 * lane + 128 * (j >> 1) + (j & 1)) * 4;
      nw[j] = *(const f32x4*)(p.norm_w + k); sh[j] = *(const f32x4*)(ad + k);
      const f32x4 sc4 = *(const f32x4*)(ad + 1024 + k);
#pragma unroll
      for (int e = 0; e < 4; ++e) nw[j][e] *= 1.f + sc4[e];
    }
#pragma unroll
    for (int q = 0; q < 4; ++q) {
      float ss = 0.f;
#pragma unroll
      for (int j = 0; j < 4; ++j) ss += v4[q][j][0] * v4[q][j][0] + v4[q][j][1] * v4[q][j][1] + v4[q][j][2] * v4[q][j][2] + v4[q][j][3] * v4[q][j][3];
#pragma unroll
      for (int o = 1; o < 64; o <<= 1) ss += __shfl_xor(ss, o);
      const float rstd = rsqrtf(ss * (1.f / DM) + 1e-6f);
#pragma unroll
      for (int i = 0; i < 2; ++i) {
        u32x4 w;
#pragma unroll
        for (int jj = 0; jj < 2; ++jj) {
          const int j = 2 * i + jj;
          float o[4];
#pragma unroll
          for (int e = 0; e < 4; ++e) o[e] = (v4[q][j][e] * rstd) * nw[j][e] + sh[j][e];
          w[2 * jj] = pk_bf16(o[0], o[1]); w[2 * jj + 1] = pk_bf16(o[2], o[3]);
        }
        *(u32x4*)(p.H + (size_t)(rowa + q) * DM + (2 * lane + 128 * i) * 4) = w;
      }
    }
  }
}

template <int RM, int CN, int WR, int WC, bool SUMSQ, int BK = 64, bool FDB = false>
DI void gemm_tile_core(const bf16_t* __restrict__ Rg, int ldr, const bf16_t* __restrict__ Cg, int ldc, int K, char* smem,
                       f32x16 (&acc)[RM / WR / 32][CN / WC / 32], float* sumsq,
                       u32x4 (&rr)[2][RM * BK / 2048], u32x4 (&cr)[2][CN * BK / 2048], float (&ssn)[CN * BK / 2048], long dR, long dC, bool cold) {
  constexpr int MI = RM / WR / 32, NI = CN / WC / 32, STR = BK + 8, CPR = BK / 8, RPP = 256 / CPR, KS = BK / 16;
  constexpr int RCH = RM / RPP, CCH = CN / RPP, BUFE = (RM + CN) * STR;
  bf16_t* lds = (bf16_t*)smem;
  const int tid = threadIdx.x, lane = tid & 63, wave = tid >> 6, r = lane & 31, h = lane >> 5;
  const int wr = wave / WC, wc = wave % WC;
  const int srow = tid / CPR, skc = (tid % CPR) * 8;
  float ss[CCH];
#pragma unroll
  for (int i = 0; i < CCH; ++i) { ss[i] = (SUMSQ && !cold) ? ssn[i] : 0.f; ssn[i] = 0.f; }
#pragma unroll
  for (int mi = 0; mi < MI; ++mi)
#pragma unroll
    for (int ni = 0; ni < NI; ++ni)
#pragma unroll
      for (int i = 0; i < 16; ++i) acc[mi][ni][i] = 0.f;
  const bf16_t* rp = Rg + (size_t)srow * ldr + skc;
  const bf16_t* cp = Cg + (size_t)srow * ldc + skc;
  const int nk = K / BK;
#define GT_LOAD(SET, KT) { const int k0_ = (KT) * BK; \
    _Pragma("unroll") for (int i = 0; i < RCH; ++i) rr[SET][i] = *(const u32x4*)(rp + (size_t)(RPP * i) * ldr + k0_); \
    _Pragma("unroll") for (int i = 0; i < CCH; ++i) cr[SET][i] = *(const u32x4*)(cp + (size_t)(RPP * i) * ldc + k0_); \
    __builtin_amdgcn_sched_barrier(0); }
#define GT_WRITE(SET, BUF, COUNT) { \
    _Pragma("unroll") for (int i = 0; i < RCH; ++i) *(u32x4*)((BUF) + (srow + RPP * i) * STR + skc) = rr[SET][i]; \
    _Pragma("unroll") for (int i = 0; i < CCH; ++i) *(u32x4*)((BUF) + (RM + srow + RPP * i) * STR + skc) = cr[SET][i]; \
    if (SUMSQ && (COUNT)) { _Pragma("unroll") for (int i = 0; i < CCH; ++i) { _Pragma("unroll") for (int e = 0; e < 4; ++e) { const float a_ = bf_lo(cr[SET][i][e]), b_ = bf_hi(cr[SET][i][e]); ss[i] += a_ * a_ + b_ * b_; } } } }
  if (cold) {
    GT_LOAD(0, 0)
    GT_LOAD(1, 1)
    GT_WRITE(0, lds, true)
    GT_LOAD(0, (2 < nk) ? 2 : nk - 1)
    __syncthreads();
  }
  for (int kt2 = 0; kt2 < nk; kt2 += 2) {
#pragma unroll
    for (int st = 0; st < 2; ++st) {
      const int kt = kt2 + st;
      const bf16_t* cur = lds + st * BUFE;
      bf16_t* oth = lds + (st ^ 1) * BUFE;
      const long k0r = (kt + 3 < nk) ? (long)(kt + 3) * BK : dR + (long)(kt + 3 - nk) * BK;
      const long k0c = (kt + 3 < nk) ? (long)(kt + 3) * BK : dC + (long)(kt + 3 - nk) * BK;
      const bool cnt = kt + 1 < nk;
      const bf16_t* abase = cur + (wr * (RM / WR) + r) * STR + h * 8;
      const bf16_t* bbase = cur + (RM + wc * (CN / WC) + r) * STR + h * 8;
      bf16x8 af[2][MI], bfr[2][NI];
      if (FDB) {
#pragma unroll
        for (int mi = 0; mi < MI; ++mi) af[0][mi] = *(const bf16x8*)(abase + mi * 32 * STR);
#pragma unroll
        for (int ni = 0; ni < NI; ++ni) bfr[0][ni] = *(const bf16x8*)(bbase + ni * 32 * STR);
      }
#pragma unroll
      for (int ks = 0; ks < KS; ++ks) {
        if (FDB && ks + 1 < KS) {
#pragma unroll
          for (int mi = 0; mi < MI; ++mi) af[(ks + 1) & 1][mi] = *(const bf16x8*)(abase + mi * 32 * STR + (ks + 1) * 16);
#pragma unroll
          for (int ni = 0; ni < NI; ++ni) bfr[(ks + 1) & 1][ni] = *(const bf16x8*)(bbase + ni * 32 * STR + (ks + 1) * 16);
        }
        if (!FDB) {
#pragma unroll
          for (int mi = 0; mi < MI; ++mi) af[ks & 1][mi] = *(const bf16x8*)(abase + mi * 32 * STR + ks * 16);
#pragma unroll
          for (int ni = 0; ni < NI; ++ni) bfr[ks & 1][ni] = *(const bf16x8*)(bbase + ni * 32 * STR + ks * 16);
        }
#pragma unroll
        for (int c = ks; c < RCH; c += KS) *(u32x4*)(oth + (srow + RPP * c) * STR + skc) = rr[st ^ 1][c];
#pragma unroll
        for (int c = ks; c < CCH; c += KS) {
          *(u32x4*)(oth + (RM + srow + RPP * c) * STR + skc) = cr[st ^ 1][c];
          if (SUMSQ) {
            float q_ = 0.f;
#pragma unroll
            for (int e = 0; e < 4; ++e) { const float a_ = bf_lo(cr[st ^ 1][c][e]), b_ = bf_hi(cr[st ^ 1][c][e]); q_ += a_ * a_ + b_ * b_; }
            if (cnt) ss[c] += q_; else if (kt + 1 == nk) ssn[c] += q_;
          }
        }
#pragma unroll
        for (int c = ks; c < RCH; c += KS) rr[st ^ 1][c] = *(const u32x4*)(rp + (size_t)(RPP * c) * ldr + k0r);
#pragma unroll
        for (int c = ks; c < CCH; c += KS) cr[st ^ 1][c] = *(const u32x4*)(cp + (size_t)(RPP * c) * ldc + k0c);
        __builtin_amdgcn_sched_barrier(0);
#pragma unroll
        for (int mi = 0; mi < MI; ++mi)
#pragma unroll
          for (int ni = 0; ni < NI; ++ni) acc[mi][ni] = MFMA32(af[ks & 1][mi], bfr[ks & 1][ni], acc[mi][ni]);
        __builtin_amdgcn_sched_barrier(0);
      }
      __syncthreads();
    }
  }
#undef GT_LOAD
#undef GT_WRITE
  if (SUMSQ) {
#pragma unroll
    for (int i = 0; i < CCH; ++i) {
      float s = ss[i];
      s += __shfl_xor(s, 1); s += __shfl_xor(s, 2);
      if (CPR == 8) s += __shfl_xor(s, 4);
      if ((tid % CPR) == 0) sumsq[srow + RPP * i] = s;
    }
  }
  __syncthreads();
}

template <int RM, int CN, int WR, int WC, bool SUMSQ, bool FDB = false>
DI void gemm_tile(const bf16_t* __restrict__ Rg, int ldr, const bf16_t* __restrict__ Cg, int ldc, int K, char* smem,
                  f32x16 (&acc)[RM / WR / 32][CN / WC / 32], float* sumsq) {
  u32x4 rr[2][RM / 32], cr[2][CN / 32];
  float ssn[CN / 32];
  gemm_tile_core<RM, CN, WR, WC, SUMSQ, 64, FDB>(Rg, ldr, Cg, ldc, K, smem, acc, sumsq, rr, cr, ssn, 0, 0, true);
}

template <int NI>
DI void p2_store_group(const Params& p, const f32x16 (&a)[NI], int colg, int tok0, int b, int h) {
  if (colg >= INC) return;
  bf16_t* base; int stride, mode = 0, use_s = 0; float scale = 1.f;
  if (colg < 1536) {
    const int which = colg >> 9, hh = (colg & 511) >> 6, d0 = colg & 63;
    base = (which == 0 ? p.Qsb : (which == 1 ? p.Ksb : p.Vsb)) + (size_t)(b * 8 + hh) * S_ * 64 + d0; stride = 64; use_s = 1;
    if (which == 0) scale = 0.125f * LOG2E;
  } else if (colg < 2048) { base = p.Gate + (colg - 1536); stride = 1024; mode = 1; }
  else if (colg < 2432) { base = p.CQ + (colg - 2048); stride = 384; }
  else if (colg < 2688) { base = p.CKV + (colg - 2432); stride = 256; }
  else if (colg < 2720) { base = nullptr; stride = 32; mode = 2; }
  else { base = p.Gate + 512 + (colg - 2720); stride = 1024; mode = 1; }
#pragma unroll
  for (int ni = 0; ni < NI; ++ni) {
    const int token = tok0 + ni * 32;
    const int idx = use_s ? (token & (S_ - 1)) : token;
    if (mode == 2) {
      float* d = p.KR + (size_t)token * 32 + 4 * h;
#pragma unroll
      for (int g = 0; g < 4; ++g) { f32x4 v = {a[ni][4 * g], a[ni][4 * g + 1], a[ni][4 * g + 2], a[ni][4 * g + 3]}; *(f32x4*)(d + 8 * g) = v; }
    } else {
      bf16_t* d = base + (size_t)idx * stride + 8 * h;
#pragma unroll
      for (int q = 0; q < 2; ++q) {
        u32x2 w[2];
#pragma unroll
        for (int gg = 0; gg < 2; ++gg) {
          const int g = 2 * q + gg;
          float v0 = a[ni][4 * g] * scale, v1 = a[ni][4 * g + 1] * scale, v2 = a[ni][4 * g + 2] * scale, v3 = a[ni][4 * g + 3] * scale;
          if (mode == 1) { v0 = silu_f(v0); v1 = silu_f(v1); v2 = silu_f(v2); v3 = silu_f(v3); }
          w[gg].x = pk_bf16(v0, v1); w[gg].y = pk_bf16(v2, v3);
        }
        *(u32x4*)(d + 16 * q) = widen_pair(w[0], w[1]);
        __builtin_amdgcn_sched_barrier(0);
      }
    }
  }
}

DI void phase2(const Params& p, char* smem, const Sched sc) {
  const int tid = threadIdx.x, lane = tid & 63, wave = tid >> 6, r = lane & 31, h = lane >> 5, wr = wave >> 1, wc = wave & 1;
  constexpr int NFULL = 384, NLIST = 16 * 26;
  u32x4 rr[2][4], cr[2][4];
  float ssn2[4];
  for (int v = sc.xi; v < 8; v += sc.nx) {
    bool cold = true;
    for (int l = sc.rank; l < NFULL; l += sc.nloc) {
      const int g8 = l / (8 * 26), rem = l % (8 * 26), nt = rem >> 3, mt = 16 * v + 8 * g8 + (rem & 7), m0 = mt * 128, n0 = nt * 128;
      const int l2 = l + sc.nloc;
      long dR = 0, dC = 0;
      if (l2 < NFULL) {
        const int g8n = l2 / (8 * 26), remn = l2 % (8 * 26), ntn = remn >> 3, mtn = 16 * v + 8 * g8n + (remn & 7);
        dR = (long)(ntn * 128 - n0) * DM; dC = (long)(mtn * 128 - m0) * DM;
      }
      f32x16 acc[2][2];
      gemm_tile_core<128, 128, 2, 2, false, 64, true>(p.WinT + (size_t)n0 * DM, DM, p.H + (size_t)m0 * DM, DM, DM, smem, acc, nullptr, rr, cr, ssn2, dR, dC, cold);
      cold = false;
#pragma unroll
      for (int mi = 0; mi < 2; ++mi) p2_store_group<2>(p, acc[mi], n0 + wr * 64 + mi * 32, m0 + wc * 64 + r, m0 >> 13, h);
    }
    for (int hl = sc.rank; hl < 2 * (NLIST - NFULL); hl += sc.nloc) {
      const int l = NFULL + (hl >> 1);
      const int g8 = l / (8 * 26), rem = l % (8 * 26), nt = rem >> 3, mt = 16 * v + 8 * g8 + (rem & 7), m0 = mt * 128, n0 = nt * 128 + 64 * (hl & 1);
      if (n0 >= INC) continue;
      f32x16 acc[2][1];
      gemm_tile<64, 128, 1, 4, false>(p.WinT + (size_t)n0 * DM, DM, p.H + (size_t)m0 * DM, DM, DM, smem, acc, nullptr);
#pragma unroll
      for (int mi = 0; mi < 2; ++mi) p2_store_group<1>(p, acc[mi], n0 + mi * 32, m0 + wave * 32 + r, m0 >> 13, h);
    }
  }
}

template <int MODE>
DI void phase3_body(const Params& p, char* smem, const Sched sc) {
  const int tid = threadIdx.x, lane = tid & 63, wave = tid >> 6, r = lane & 31, h = lane >> 5;
  u32x4 rrw[2][MODE == 1 ? 3 : 4], crw[2][4];
  float ssw[4];
  bool cold = true;
  float* sumsq = (float*)(smem + 2 * 256 * 72 * 2);
  float* hnw = sumsq + 128;
  if (tid < 192) hnw[tid] = tid < 96 ? p.qhn[tid] : p.khn[tid - 96];
  __syncthreads();
  for (int v = sc.xi; v < 8; v += sc.nx)
  for (int l = sc.rank; l < 16 * 16; l += sc.nloc) {
    const int mt = 16 * v + (l >> 4), sub = l & 15, head = sub & 7, m0 = mt * 128;
    const int tl = wave * 32 + r, token = m0 + tl, b = token >> 13, s = token & (S_ - 1);
    long dC = 0;
    if (MODE != 0) {
      int v2 = v, l2 = l + sc.nloc;
      if (l2 >= 16 * 16) { v2 = v + sc.nx; l2 = sc.rank; }
      if (v2 < 8 && l2 < 16 * 16) dC = (long)((16 * v2 + (l2 >> 4)) - mt) * 128;
    }
    if (MODE != 2 && sub < 8) {
      f32x16 acc[3][1];
      if constexpr (MODE == 1) { gemm_tile_core<96, 128, 1, 4, true, 64, false>(p.WuqT + (size_t)head * 96 * 384, 384, p.CQ + (size_t)m0 * 384, 384, 384, smem, acc, sumsq, rrw, crw, ssw, 0, dC * 384, cold); cold = false; }
      else gemm_tile<96, 128, 1, 4, true>(p.WuqT + (size_t)head * 96 * 384, 384, p.CQ + (size_t)m0 * 384, 384, 384, smem, acc, sumsq);
      const float rstd = rsqrtf(sumsq[tl] * (1.f / 384) + 1e-6f);
      float ssq = 0.f;
#pragma unroll
      for (int rb = 0; rb < 3; ++rb)
#pragma unroll
        for (int i = 0; i < 16; ++i) { const float v = acc[rb][0][i] * rstd; acc[rb][0][i] = v; ssq += v * v; }
      ssq += __shfl_xor(ssq, 32);
      const float r2 = rsqrtf(ssq * (1.f / 96) + 1e-6f);
#pragma unroll
      for (int rb = 0; rb < 3; ++rb)
#pragma unroll
        for (int g = 0; g < 4; ++g) {
          const f32x4 w4 = *(const f32x4*)(hnw + rb * 32 + 8 * g + 4 * h);
#pragma unroll
          for (int e = 0; e < 4; ++e) acc[rb][0][4 * g + e] *= r2 * w4[e];
        }
#pragma unroll
      for (int g = 0; g < 2; ++g) {
        const f32x4 c4 = *(const f32x4*)(p.cosT + (size_t)token * 16 + 8 * g + 4 * h), s4 = *(const f32x4*)(p.sinT + (size_t)token * 16 + 8 * g + 4 * h);
#pragma unroll
        for (int e = 0; e < 4; ++e) {
          const float x1 = acc[2][0][4 * g + e], x2 = acc[2][0][4 * (g + 2) + e];
          acc[2][0][4 * g + e] = x1 * c4[e] - x2 * s4[e];
          acc[2][0][4 * (g + 2) + e] = x2 * c4[e] + x1 * s4[e];
        }
      }
      const float qs = LOG2E * 0.10206207261596577f;
      bf16_t* dst = p.Qm + ((size_t)(b * 8 + head) * S_ + s) * 96;
#pragma unroll
      for (int rb = 0; rb < 3; ++rb) {
        u32x2 w[4];
#pragma unroll
        for (int g = 0; g < 4; ++g) { w[g].x = pk_bf16(acc[rb][0][4 * g] * qs, acc[rb][0][4 * g + 1] * qs); w[g].y = pk_bf16(acc[rb][0][4 * g + 2] * qs, acc[rb][0][4 * g + 3] * qs); }
#pragma unroll
        for (int q = 0; q < 2; ++q) *(u32x4*)(dst + rb * 32 + 16 * q + 8 * h) = widen_pair(w[2 * q], w[2 * q + 1]);
      }
    } else if (MODE != 1) {
      f32x16 acc[4][1];
      if constexpr (MODE == 2) { gemm_tile_core<128, 128, 1, 4, true, 64, false>(p.WukvT + (size_t)head * 128 * 256, 256, p.CKV + (size_t)m0 * 256, 256, 256, smem, acc, sumsq, rrw, crw, ssw, 0, dC * 256, cold); cold = false; }
      else gemm_tile<128, 128, 1, 4, true>(p.WukvT + (size_t)head * 128 * 256, 256, p.CKV + (size_t)m0 * 256, 256, 256, smem, acc, sumsq);
      const float rstd = rsqrtf(sumsq[tl] * (1.f / 256) + 1e-6f);
      float kr[16];
#pragma unroll
      for (int g = 0; g < 4; ++g) {
        const f32x4 k4 = *(const f32x4*)(p.KR + (size_t)token * 32 + 8 * g + 4 * h);
#pragma unroll
        for (int e = 0; e < 4; ++e) kr[4 * g + e] = k4[e];
      }
      float ssq = 0.f;
#pragma unroll
      for (int rb = 0; rb < 2; ++rb)
#pragma unroll
        for (int i = 0; i < 16; ++i) { const float v = acc[rb][0][i] * rstd; acc[rb][0][i] = v; ssq += v * v; }
#pragma unroll
      for (int i = 0; i < 16; ++i) ssq += kr[i] * kr[i];
      ssq += __shfl_xor(ssq, 32);
      const float r2 = rsqrtf(ssq * (1.f / 96) + 1e-6f);
#pragma unroll
      for (int rb = 0; rb < 2; ++rb)
#pragma unroll
        for (int g = 0; g < 4; ++g) {
          const f32x4 w4 = *(const f32x4*)(hnw + 96 + rb * 32 + 8 * g + 4 * h);
#pragma unroll
          for (int e = 0; e < 4; ++e) acc[rb][0][4 * g + e] *= r2 * w4[e];
        }
#pragma unroll
      for (int g = 0; g < 4; ++g) {
        const f32x4 w4 = *(const f32x4*)(hnw + 96 + 64 + 8 * g + 4 * h);
#pragma unroll
        for (int e = 0; e < 4; ++e) kr[4 * g + e] *= r2 * w4[e];
      }
#pragma unroll
      for (int g = 0; g < 2; ++g) {
        const f32x4 c4 = *(const f32x4*)(p.cosT + (size_t)token * 16 + 8 * g + 4 * h), s4 = *(const f32x4*)(p.sinT + (size_t)token * 16 + 8 * g + 4 * h);
#pragma unroll
        for (int e = 0; e < 4; ++e) {
          const float x1 = kr[4 * g + e], x2 = kr[4 * (g + 2) + e];
          kr[4 * g + e] = x1 * c4[e] - x2 * s4[e];
          kr[4 * (g + 2) + e] = x2 * c4[e] + x1 * s4[e];
        }
      }
      bf16_t* dk = p.Km + ((size_t)(b * 8 + head) * S_ + s) * 96;
      bf16_t* dv = p.Vm + ((size_t)(b * 8 + head) * S_ + s) * 64;
#pragma unroll
      for (int rb = 0; rb < 2; ++rb) {
        u32x2 w[4], u[4];
#pragma unroll
        for (int g = 0; g < 4; ++g) {
          w[g].x = pk_bf16(acc[rb][0][4 * g], acc[rb][0][4 * g + 1]); w[g].y = pk_bf16(acc[rb][0][4 * g + 2], acc[rb][0][4 * g + 3]);
          u[g].x = pk_bf16(acc[rb + 2][0][4 * g] * rstd, acc[rb + 2][0][4 * g + 1] * rstd); u[g].y = pk_bf16(acc[rb + 2][0][4 * g + 2] * rstd, acc[rb + 2][0][4 * g + 3] * rstd);
        }
#pragma unroll
        for (int q = 0; q < 2; ++q) {
          *(u32x4*)(dk + rb * 32 + 16 * q + 8 * h) = widen_pair(w[2 * q], w[2 * q + 1]);
          *(u32x4*)(dv + rb * 32 + 16 * q + 8 * h) = widen_pair(u[2 * q], u[2 * q + 1]);
        }
      }
      {
        u32x2 w[4];
#pragma unroll
        for (int g = 0; g < 4; ++g) { w[g].x = pk_bf16(kr[4 * g], kr[4 * g + 1]); w[g].y = pk_bf16(kr[4 * g + 2], kr[4 * g + 3]); }
#pragma unroll
        for (int q = 0; q < 2; ++q) *(u32x4*)(dk + 64 + 16 * q + 8 * h) = widen_pair(w[2 * q], w[2 * q + 1]);
      }
    }
  }
}

DI void phase3(const Params& p, char* smem, const Sched sc) {
  if ((sc.nloc & 15) == 0) {
    if ((sc.rank & 15) < 8) phase3_body<1>(p, smem, sc);
    else phase3_body<2>(p, smem, sc);
  } else phase3_body<0>(p, smem, sc);
}

template <int DQK, bool SB, bool SMAX>
DI void attn_item(const Params& p, char* smem, int bh, int qb, float Mb) {
  constexpr int KSTR = DQK + 8, VSTR = 72, NKS = DQK / 16, KCH = DQK / 8, KPT = 64 * KCH / 256, KBUF = 64 * KSTR, VBUF = 64 * VSTR;
  bf16_t* Ks = (bf16_t*)smem;
  bf16_t* Vs = Ks + 2 * KBUF;
  int* flags = (int*)(Vs + 2 * VBUF);
  const bf16_t* Qg = SB ? p.Qsb : p.Qm;
  const bf16_t* Kg = (SB ? p.Ksb : p.Km) + (size_t)bh * S_ * DQK;
  const bf16_t* Vg = (SB ? p.Vsb : p.Vm) + (size_t)bh * S_ * 64;
  const int tid = threadIdx.x, lane = tid & 63, wave = tid >> 6, r = lane & 31, h = lane >> 5;
  const int q0 = qb * 128, qw0 = q0 + wave * 32, query = qw0 + r;
  bf16x8 qf[NKS];
  {
    const bf16_t* qp = Qg + ((size_t)bh * S_ + query) * DQK + h * 8;
#pragma unroll
    for (int ks = 0; ks < NKS; ++ks) qf[ks] = *(const bf16x8*)(qp + ks * 16);
  }
  bf16x8 tri[2], ones;
#pragma unroll
  for (int s = 0; s < 2; ++s)
#pragma unroll
    for (int j = 0; j < 8; ++j) tri[s][j] = ((16 * s + 8 * (j >> 2) + 4 * h + (j & 3)) >= r) ? (short)0x3F80 : (short)0;
#pragma unroll
  for (int j = 0; j < 8; ++j) ones[j] = (short)0x3F80;

  const int nt = 2 * (qb + 1);
  f32x16 O[2];
#pragma unroll
  for (int db = 0; db < 2; ++db)
#pragma unroll
    for (int i = 0; i < 16; ++i) O[db][i] = 0.f;
  float m = -__builtin_huge_valf(), lsum = 0.f, carry = 0.f;
  f32x16 negM;
#pragma unroll
  for (int i = 0; i < 16; ++i) negM[i] = -Mb;

  u32x4 kreg[1][KPT], vreg[1][2];
#define AT_KB(IT) (SB ? 64 * (nt - 1 - (IT)) : 64 * (IT))
#define AT_LOAD(SET, IT) { const int kl_ = AT_KB(IT); \
    _Pragma("unroll") for (int i = 0; i < KPT; ++i) kreg[SET][i] = *(const u32x4*)(Kg + (size_t)kl_ * DQK + (tid + 256 * i) * 8); \
    _Pragma("unroll") for (int i = 0; i < 2; ++i) vreg[SET][i] = *(const u32x4*)(Vg + (size_t)kl_ * 64 + (tid + 256 * i) * 8); \
    __builtin_amdgcn_sched_barrier(0); }
#define AT_WRITE(SET, BUFI) { \
    _Pragma("unroll") for (int i = 0; i < KPT; ++i) { const int c = tid + 256 * i, row = c / KCH, kcol = c % KCH; *(u32x4*)(Ks + (BUFI) * KBUF + row * KSTR + kcol * 8) = kreg[SET][i]; } \
    _Pragma("unroll") for (int i = 0; i < 2; ++i) { const int c = tid + 256 * i; *(u32x4*)(Vs + (BUFI) * VBUF + (c >> 3) * VSTR + (c & 7) * 8) = vreg[SET][i]; } }
  const int blk = (lane >> 4) & 1, tq = (lane & 15) >> 2, tp = lane & 3;
  const int voff = (4 * h + tq) * VSTR + 16 * blk + 4 * tp;

  AT_LOAD(0, 0)
  AT_WRITE(0, 0)
  AT_LOAD(0, 1)
  __syncthreads();
  bool stop = false;
  for (int it2 = 0; it2 < nt && !stop; it2 += 2) {
#pragma unroll
   for (int st2 = 0; st2 < 2; ++st2) {
    const int it = it2 + st2;
    const int kb0 = AT_KB(it);
    const bf16_t* kc = Ks + st2 * KBUF;
    const bf16_t* vc = Vs + st2 * VBUF;
    const bool active = kb0 < qw0 + 32;
    f32x16 st[2];
    if (active) {
#pragma unroll
      for (int kb = 0; kb < 2; ++kb)
#pragma unroll
        for (int i = 0; i < 16; ++i) st[kb][i] = SMAX ? negM[i] : 0.f;
#pragma unroll
      for (int ks = 0; ks < NKS; ++ks)
#pragma unroll
        for (int kb = 0; kb < 2; ++kb) {
          const bf16x8 a = *(const bf16x8*)(kc + (kb * 32 + r) * KSTR + ks * 16 + h * 8);
          st[kb] = MFMA32(a, qf[ks], st[kb]);
        }
    }
    __builtin_amdgcn_sched_barrier(0);
    AT_WRITE(0, st2 ^ 1)
    AT_LOAD(0, (it + 2 < nt) ? it + 2 : nt - 1)
    if (active) {
      const bool diag = (kb0 + 64 > qw0);
      bf16x8 pk[4];
      if (!SB) {
        if (diag) {
#pragma unroll
          for (int kb = 0; kb < 2; ++kb)
#pragma unroll
            for (int i = 0; i < 16; ++i) { const int key = kb0 + kb * 32 + crow(i, h); if (key > query) st[kb][i] = -__builtin_huge_valf(); }
        }
        if (SMAX) {
          float ps = 0.f;
#pragma unroll
          for (int kb = 0; kb < 2; ++kb)
#pragma unroll
            for (int i = 0; i < 16; ++i) { const float pv = fast_exp2(st[kb][i]); st[kb][i] = pv; ps += pv; }
          lsum += ps;
        } else {
        float mx = st[0][0];
#pragma unroll
        for (int kb = 0; kb < 2; ++kb)
#pragma unroll
          for (int i = 0; i < 16; ++i) mx = fmaxf(mx, st[kb][i]);
        mx = fmaxf(mx, __shfl_xor(mx, 32));
        const float mnew = fmaxf(m, mx);
        const float alpha = fast_exp2(m - mnew);
        m = mnew;
        float ps = 0.f;
#pragma unroll
        for (int kb = 0; kb < 2; ++kb)
#pragma unroll
          for (int i = 0; i < 16; ++i) { const float pv = fast_exp2(st[kb][i] - mnew); st[kb][i] = pv; ps += pv; }
        lsum = lsum * alpha + ps;
#pragma unroll
        for (int db = 0; db < 2; ++db)
#pragma unroll
          for (int i = 0; i < 16; ++i) O[db][i] *= alpha;
        }
      } else {
        f32x16 ca[2];
        bf16x8 hi[4], lo[4];
        float tsum = 0.f;
#pragma unroll
        for (int kb = 0; kb < 2; ++kb)
#pragma unroll
          for (int i2 = 0; i2 < 8; ++i2) {
            float lk[2];
#pragma unroll
            for (int e = 0; e < 2; ++e) {
              const int i = 2 * i2 + e;
              const float z = fminf(st[kb][i], 100.f);
              const int key = kb0 + kb * 32 + crow(i, h);
              const bool valid = !diag || (key < query);
              float l = -fast_log2(1.f + fast_exp2(z));
              l = valid ? l : 0.f;
              lk[e] = l;
              tsum += l;
              ca[kb][i] = z + carry;
            }
            const unsigned hp = pk_bf16(lk[0], lk[1]);
            const unsigned lp = pk_bf16(lk[0] - bf_lo(hp), lk[1] - bf_hi(hp));
            const int kk = kb * 2 + (i2 >> 2), w = i2 & 3;
            hi[kk][2 * w] = (short)(hp & 0xffffu); hi[kk][2 * w + 1] = (short)(hp >> 16);
            lo[kk][2 * w] = (short)(lp & 0xffffu); lo[kk][2 * w + 1] = (short)(lp >> 16);
          }
        tsum += __shfl_xor(tsum, 32);
#pragma unroll
        for (int s = 0; s < 2; ++s) {
          ca[0] = MFMA32(tri[s], hi[s], ca[0]);
          ca[0] = MFMA32(tri[s], lo[s], ca[0]);
          ca[0] = MFMA32(ones, hi[2 + s], ca[0]);
          ca[0] = MFMA32(ones, lo[2 + s], ca[0]);
          ca[1] = MFMA32(tri[s], hi[2 + s], ca[1]);
          ca[1] = MFMA32(tri[s], lo[2 + s], ca[1]);
        }
#pragma unroll
        for (int kb = 0; kb < 2; ++kb)
#pragma unroll
          for (int i = 0; i < 16; ++i) {
            const int key = kb0 + kb * 32 + crow(i, h);
            const bool valid = !diag || (key < query);
            st[kb][i] = valid ? fast_exp2(ca[kb][i]) : 0.f;
          }
        carry += tsum;
      }
#pragma unroll
      for (int kb = 0; kb < 2; ++kb)
#pragma unroll
        for (int s = 0; s < 2; ++s) {
          u32x4 w;
#pragma unroll
          for (int e = 0; e < 4; ++e) w[e] = pk_bf16(st[kb][8 * s + 2 * e], st[kb][8 * s + 2 * e + 1]);
          pk[kb * 2 + s] = __builtin_bit_cast(bf16x8, w);
        }
#pragma unroll
      for (int kk = 0; kk < 4; ++kk)
#pragma unroll
        for (int db = 0; db < 2; ++db) {
          const s16x4 v0 = __builtin_amdgcn_ds_read_tr16_b64_v4i16((lds_s16x4*)(vc + voff + (16 * kk) * VSTR + 32 * db));
          const s16x4 v1 = __builtin_amdgcn_ds_read_tr16_b64_v4i16((lds_s16x4*)(vc + voff + (16 * kk + 8) * VSTR + 32 * db));
          const bf16x8 vf = __builtin_shufflevector(v0, v1, 0, 1, 2, 3, 4, 5, 6, 7);
          O[db] = MFMA32(vf, pk[kk], O[db]);
        }
    }
    if (SB) {
      const bool alive = __builtin_amdgcn_ballot_w64(carry > -64.f) != 0ull;
      if (lane == 0) flags[st2 * 4 + wave] = alive ? 1 : 0;
    }
    __syncthreads();
    if (SB) {
      const int any = flags[st2 * 4 + 0] | flags[st2 * 4 + 1] | flags[st2 * 4 + 2] | flags[st2 * 4 + 3];
      if (!any) { stop = true; break; }
    }
   }
  }
#undef AT_KB
#undef AT_LOAD
#undef AT_WRITE
  float inv = 1.f;
  if (!SB) { const float lt = lsum + __shfl_xor(lsum, 32); inv = 1.f / lt; }
  const size_t token = (size_t)(bh >> 3) * S_ + query;
  const int colbase = (SB ? 0 : 512) + (bh & 7) * 64;
#pragma unroll
  for (int db = 0; db < 2; ++db) {
    u32x2 w[4];
#pragma unroll
    for (int g = 0; g < 4; ++g) {
      const int col = colbase + db * 32 + 8 * g + 4 * h;
      const u32x2 gt = *(const u32x2*)(p.Gate + token * 1024 + col);
      w[g].x = pk_bf16(O[db][4 * g] * inv * bf_lo(gt.x), O[db][4 * g + 1] * inv * bf_hi(gt.x));
      w[g].y = pk_bf16(O[db][4 * g + 2] * inv * bf_lo(gt.y), O[db][4 * g + 3] * inv * bf_hi(gt.y));
    }
#pragma unroll
    for (int q = 0; q < 2; ++q) *(u32x4*)(p.Mixed + token * 1024 + colbase + db * 32 + 16 * q + 8 * h) = widen_pair(w[2 * q], w[2 * q + 1]);
  }
  __syncthreads();
}

DI void phase4(const Params& p, char* smem, const Sched sc) {
  int* s_item = (int*)(smem + LDS_BYTES - 16);
  float gq = 0.f, gk = 0.f;
  for (int i = 0; i < 96; ++i) { gq = fmaxf(gq, fabsf(p.qhn[i])); gk = fmaxf(gk, fabsf(p.khn[i])); }
  const float Mb = LOG2E * 9.797958971132712f * gq * gk * 1.02f;
  const bool smax = Mb < 56.f;
  for (int v = sc.xi; v < 8; v += sc.nx)
  for (;;) {
    if (threadIdx.x == 0) *s_item = (int)atomicAdd(&p.counters[XB_WQ(v)], 1u);
    __syncthreads();
    const int item = *s_item;
    __syncthreads();
    if (item >= 256) break;
    if (item < 128) {
      const int bh = 2 * v + (item & 1), qb = 63 - (item >> 1);
      if (smax) attn_item<96, false, true>(p, smem, bh, qb, Mb);
      else attn_item<96, false, false>(p, smem, bh, qb, 0.f);
    } else { const int j = item - 128; attn_item<64, true, false>(p, smem, 2 * v + (j & 1), 63 - (j >> 1), 0.f); }
  }
}

DI void phase5(const Params& p, char* smem, const Sched sc) {
  const int tid = threadIdx.x, lane = tid & 63, wave = tid >> 6, r = lane & 31, h = lane >> 5, wr = wave >> 1, wc = wave & 1;
  constexpr int CST = 132;
  float* ct = (float*)smem;
  for (int v = sc.xi; v < 8; v += sc.nx)
  for (int l = sc.rank; l < 16 * 8; l += sc.nloc) {
    const int g8 = l >> 6, rem = l & 63, nt = rem >> 3, mt = 16 * v + 8 * g8 + (rem & 7), m0 = mt * 128, n0 = nt * 128;
    f32x16 acc[2][2];
    gemm_tile<128, 128, 2, 2, false, true>(p.WoutT + (size_t)n0 * DM, DM, p.Mixed + (size_t)m0 * DM, DM, DM, smem, acc, nullptr);
    const int b = m0 >> 13;
#pragma unroll
    for (int mi = 0; mi < 2; ++mi)
#pragma unroll
      for (int ni = 0; ni < 2; ++ni)
#pragma unroll
        for (int g = 0; g < 4; ++g) {
          const f32x4 vv = {acc[mi][ni][4 * g], acc[mi][ni][4 * g + 1], acc[mi][ni][4 * g + 2], acc[mi][ni][4 * g + 3]};
          *(f32x4*)(ct + (wc * 64 + ni * 32 + r) * CST + wr * 64 + mi * 32 + 8 * g + 4 * h) = vv;
        }
    __syncthreads();
    const int c4 = (tid & 31) * 4, row0 = tid >> 5;
    const f32x4 gt = *(const f32x4*)(p.ada + b * 3072 + 2048 + n0 + c4);
#pragma unroll
    for (int half = 0; half < 2; ++half) {
      f32x4 xv[8];
#pragma unroll
      for (int j = 0; j < 8; ++j) xv[j] = *(const f32x4*)(p.x + (size_t)(m0 + row0 + 8 * (half * 8 + j)) * DM + n0 + c4);
#pragma unroll
      for (int j = 0; j < 8; ++j) {
        const int row = row0 + 8 * (half * 8 + j);
        const f32x4 cv = *(const f32x4*)(ct + row * CST + c4);
        f32x4 o;
#pragma unroll
        for (int e = 0; e < 4; ++e) o[e] = xv[j][e] + gt[e] * cv[e];
        *(f32x4*)(p.out + (size_t)(m0 + row) * DM + n0 + c4) = o;
      }
    }
    __syncthreads();
  }
}

#if !ONE_LAUNCH
template <int PH>
__global__ void __launch_bounds__(256, 2) k_phase(Params p) {
  __shared__ __attribute__((aligned(16))) char smem[LDS_BYTES];
  const int bid = blockIdx.x, nb = gridDim.x;
  Sched sc; sc.xi = bid & 7; sc.nx = 8; sc.rank = bid >> 3; sc.nloc = nb >> 3;
  if (PH == 0) phase0(p, smem, bid, nb);
  if (PH == 1) phase1(p, sc);
  if (PH == 2) phase2(p, smem, sc);
  if (PH == 3) phase3(p, smem, sc);
  if (PH == 4) phase4(p, smem, sc);
  if (PH == 5) phase5(p, smem, sc);
}

#else
__global__ void __launch_bounds__(256, 2) k_mega(Params p) {
  __shared__ __attribute__((aligned(16))) char smem[LDS_BYTES];
  __shared__ uint4 xb_words;
  if (p.out == nullptr) cg::this_grid().sync();
  const int bid = blockIdx.x, nb = gridDim.x;
  if (threadIdx.x == 0) xb_words = make_uint4(0u, 0u, 0u, 0u);
  __syncthreads();
  const XcdBarrier xb = xcd_barrier_post(p.counters, (volatile LAS unsigned*)&xb_words);
  phase0(p, smem, bid, nb);
  xcd_census(xb);
  xcd_barrier(xb);
  Sched sc; sc.nloc = (int)xb_words.x; sc.nx = (int)xb_words.y; sc.rank = (int)xb_words.z; sc.xi = (int)xb_words.w;
  if (__builtin_amdgcn_readfirstlane(sc.rank) * 2 >= __builtin_amdgcn_readfirstlane(sc.nloc)) __builtin_amdgcn_s_setprio(1);
  phase1(p, sc);
  xcd_local_barrier(xb);
  phase2(p, smem, sc);
  xcd_local_barrier(xb);
  phase3(p, smem, sc);
  xcd_barrier(xb);
  phase4(p, smem, sc);
  xcd_barrier(xb);
  phase5(p, smem, sc);
}

#endif

extern "C" void kernel_launch(void* const* d_in, const int* in_sizes, int n_in, void* d_out, int out_size, void* d_ws, size_t ws_size, hipStream_t stream) {
  Params p{};
  p.x = (const float*)d_in[0]; p.c = (const float*)d_in[1]; p.pos = (const int*)d_in[2];
  p.w_ada = (const float*)d_in[3]; p.b_ada = (const float*)d_in[4]; p.norm_w = (const float*)d_in[5]; p.w_in = (const float*)d_in[6];
  p.qln = (const float*)d_in[7]; p.w_uq = (const float*)d_in[8]; p.kvln = (const float*)d_in[9]; p.w_ukv = (const float*)d_in[10];
  p.qhn = (const float*)d_in[11]; p.khn = (const float*)d_in[12]; p.w_out = (const float*)d_in[13];
  p.out = (float*)d_out;
  char* w = (char*)d_ws;
  size_t off = 0;
  auto take = [&](size_t bytes) { char* q = w + off; off += (bytes + 255) & ~(size_t)255; return q; };
  p.ada = (float*)take(2 * 3072 * 4);
  p.counters = (unsigned*)take(XB_TOTAL_WORDS * 4);
  p.cosT = (float*)take((size_t)NTOK * 16 * 4);
  p.sinT = (float*)take((size_t)NTOK * 16 * 4);
  p.WinT = (bf16_t*)take((size_t)INPAD * 1024 * 2);
  p.WuqT = (bf16_t*)take((size_t)768 * 384 * 2);
  p.WukvT = (bf16_t*)take((size_t)1024 * 256 * 2);
  p.WoutT = (bf16_t*)take((size_t)1024 * 1024 * 2);
  p.H = (bf16_t*)take((size_t)NTOK * 1024 * 2);
  p.Qsb = (bf16_t*)take((size_t)NTOK * 512 * 2);
  p.Ksb = (bf16_t*)take((size_t)NTOK * 512 * 2);
  p.Vsb = (bf16_t*)take((size_t)NTOK * 512 * 2);
  p.Gate = (bf16_t*)take((size_t)NTOK * 1024 * 2);
  p.CQ = (bf16_t*)take((size_t)NTOK * 384 * 2);
  p.CKV = (bf16_t*)take((size_t)NTOK * 256 * 2);
  p.KR = (float*)take((size_t)NTOK * 32 * 4);
  p.Qm = (bf16_t*)take((size_t)NTOK * 768 * 2);
  p.Km = (bf16_t*)take((size_t)NTOK * 768 * 2);
  p.Vm = (bf16_t*)take((size_t)NTOK * 512 * 2);
  p.Mixed = p.H;
  hipMemsetAsync(p.counters, 0, XB_TOTAL_WORDS * 4, stream);
#if ONE_LAUNCH
  static int grid_blocks = 0;
  if (!grid_blocks) {
    int dev = 0, cus = 0, per_cu = 0;
    hipGetDevice(&dev);
    hipDeviceGetAttribute(&cus, hipDeviceAttributeMultiprocessorCount, dev);
    hipOccupancyMaxActiveBlocksPerMultiprocessor(&per_cu, k_mega, 256, 0);
    if (per_cu > 2) per_cu = 2;
    if (per_cu < 1) per_cu = 1;
    grid_blocks = cus * per_cu;
  }
  void* args[] = {&p};
  hipError_t e = hipLaunchCooperativeKernel((void*)k_mega, dim3(grid_blocks), dim3(256), args, 0, stream);
  if (e != hipSuccess) fprintf(stderr, "cooperative launch failed: %s (grid %d)\n", hipGetErrorString(e), grid_blocks);
#else
  const int G = 512;
#ifndef DUP_PHASE
#define DUP_PHASE -1
#endif
  k_phase<0><<<G, 256, 0, stream>>>(p);
  if (DUP_PHASE == 0) k_phase<0><<<G, 256, 0, stream>>>(p);
  k_phase<1><<<G, 256, 0, stream>>>(p);
  if (DUP_PHASE == 1) k_phase<1><<<G, 256, 0, stream>>>(p);
  k_phase<2><<<G, 256, 0, stream>>>(p);
  if (DUP_PHASE == 2) k_phase<2><<<G, 256, 0, stream>>>(p);
  k_phase<3><<<G, 256, 0, stream>>>(p);
  if (DUP_PHASE == 3) k_phase<3><<<G, 256, 0, stream>>>(p);
  k_phase<4><<<G, 256, 0, stream>>>(p);
  if (DUP_PHASE == 4) { hipMemsetAsync(p.counters, 0, XB_TOTAL_WORDS * 4, stream); k_phase<4><<<G, 256, 0, stream>>>(p); }
  k_phase<5><<<G, 256, 0, stream>>>(p);
  if (DUP_PHASE == 5) k_phase<5><<<G, 256, 0, stream>>>(p);
#endif
}
```

```cpp
#include <hip/hip_runtime.h>
#include <hip/hip_cooperative_groups.h>
#include <cstdio>
#include <cstdint>
namespace cg = cooperative_groups;

#ifndef ONE_LAUNCH
#define ONE_LAUNCH 1
#endif

typedef unsigned short bf16_t;
typedef short bf16x8 __attribute__((ext_vector_type(8)));
typedef short s16x4 __attribute__((ext_vector_type(4)));
typedef float f32x16 __attribute__((ext_vector_type(16)));
typedef float f32x4 __attribute__((ext_vector_type(4)));
typedef float f32x2 __attribute__((ext_vector_type(2)));
typedef __bf16 bf2_t __attribute__((ext_vector_type(2)));
typedef unsigned u32x4 __attribute__((ext_vector_type(4)));
typedef unsigned u32x2 __attribute__((ext_vector_type(2)));
typedef __attribute__((address_space(3))) s16x4 lds_s16x4;

#define DI __device__ __forceinline__
#define MFMA32(a, b, c) __builtin_amdgcn_mfma_f32_32x32x16_bf16((a), (b), (c), 0, 0, 0)

constexpr int S_ = 8192, NTOK = 16384, DM = 1024, INC = 3232, INPAD = 3328;
constexpr float LOG2E = 1.4426950408889634f;
constexpr int LDS_BYTES = 2 * 256 * 72 * 2 + 1024;

__device__ const float kInvFreq[16] = {1.0f, 0.5623413324356079f, 0.3162277638912201f, 0.17782793939113617f, 0.10000000149011612f, 0.05623413249850273f, 0.03162277489900589f, 0.017782794311642647f, 0.009999999776482582f, 0.005623413249850273f, 0.003162277629598975f, 0.0017782794311642647f, 0.0010000000474974513f, 0.000562341301701963f, 0.0003162277571391314f, 0.00017782794020604342f};

struct Params {
  const float *x, *c; const int* pos; const float *w_ada, *b_ada, *norm_w, *w_in, *qln, *w_uq, *kvln, *w_ukv, *qhn, *khn, *w_out;
  float* out;
  float* ada; unsigned* counters; float* cosT; float* sinT;
  bf16_t *WinT, *WuqT, *WukvT, *WoutT, *H, *Qsb, *Ksb, *Vsb, *Gate, *CQ, *CKV; float* KR; bf16_t *Qm, *Km, *Vm, *Mixed;
};

DI unsigned pk_bf16(float lo, float hi) { f32x2 v = {lo, hi}; bf2_t b = __builtin_convertvector(v, bf2_t); return __builtin_bit_cast(unsigned, b); }
DI bf16_t to_bf16(float x) { return (bf16_t)(pk_bf16(x, 0.f) & 0xffffu); }
DI float bf_lo(unsigned u) { return __uint_as_float(u << 16); }
DI float bf_hi(unsigned u) { return __uint_as_float(u & 0xffff0000u); }
DI int crow(int i, int h) { return (i & 3) + 8 * (i >> 2) + 4 * h; }
DI u32x4 widen_pair(u32x2 a, u32x2 b) {
  const auto rx = __builtin_amdgcn_permlane32_swap(a.x, b.x, false, false);
  const auto ry = __builtin_amdgcn_permlane32_swap(a.y, b.y, false, false);
  const u32x4 w = {rx[0], ry[0], rx[1], ry[1]};
  return w;
}
DI float fast_exp2(float x) { return __builtin_amdgcn_exp2f(x); }
DI float fast_log2(float x) { return __builtin_amdgcn_logf(x); }
DI float silu_f(float v) { return v * __builtin_amdgcn_rcpf(1.f + fast_exp2(-v * LOG2E)); }


#define XB_TMO      128
#define XB_XCNT(j)  (256  + 64 * (j))
#define XB_XSUB(j)  (1280 + 64 * (j))
#define XB_XGEN(j)  (2304 + 64 * (j))
#define XB_TOP      3328
#define XB_TOPGEN   3392
#define XCD_BAR_WORDS 3456
#define XB_WQ(v)    (3520 + 64 * (v))
#define XB_LSUB(j)  (4096 + 64 * (j))
#define XB_LGEN(j)  (5120 + 64 * (j))
#define XB_TOTAL_WORDS 6144
#define XB_SPIN_CAP (1u << 22)
#define LAS __attribute__((address_space(3)))
DI unsigned xb_ld(unsigned* p) { return __hip_atomic_load(p, __ATOMIC_RELAXED, __HIP_MEMORY_SCOPE_AGENT); }
DI unsigned xb_add(unsigned* p, unsigned v) { return __hip_atomic_fetch_add(p, v, __ATOMIC_RELAXED, __HIP_MEMORY_SCOPE_AGENT); }
DI unsigned xb_xcc_id() { return (unsigned)__builtin_amdgcn_s_getreg((3 << 11) | 20) & 0xFu; }
#define XB_SPIN(cond, bar) do { unsigned _sp = 0; while (cond) { __builtin_amdgcn_s_sleep(1); \
    if ((++_sp & 255u) == 0u) { if (xb_ld(&(bar)[XB_TMO])) break; if (_sp > XB_SPIN_CAP) { atomicAdd(&(bar)[XB_TMO], 1u); break; } } } } while (0)
struct XcdBarrier { unsigned* bar; unsigned x; volatile LAS unsigned* st; };
DI XcdBarrier xcd_barrier_post(unsigned* bar, volatile LAS unsigned* st) {
  XcdBarrier b; b.bar = bar; b.x = xb_xcc_id(); b.st = st;
  if (threadIdx.x == 0) st[2] = xb_add(&bar[XB_XCNT(b.x)], 1u);
  return b;
}
DI void xcd_barrier_complete(unsigned* bar, unsigned x, unsigned& nloc, unsigned& nx, unsigned& xi) {
  const unsigned G = gridDim.x * gridDim.y * gridDim.z;
  unsigned sum, cnt, mine, below, sp = 0u;
  for (;;) {
    sum = 0u; cnt = 0u; mine = 0u; below = 0u;
#pragma unroll
    for (unsigned j = 0; j < 16; ++j) { const unsigned c = xb_ld(&bar[XB_XCNT(j)]); sum += c; cnt += (c > 0u) ? 1u : 0u; mine = (j == x) ? c : mine; below += (j < x && c > 0u) ? 1u : 0u; }
    if (sum == G) break;
    __builtin_amdgcn_s_sleep(1);
    if ((++sp & 255u) == 0u) { if (xb_ld(&bar[XB_TMO])) break; if (sp > XB_SPIN_CAP) { atomicAdd(&bar[XB_TMO], 1u); break; } }
  }
  nloc = mine > 0u ? mine : 1u; nx = cnt > 0u ? cnt : 1u; xi = below;
}
DI void xcd_census(const XcdBarrier& b) {
  if (threadIdx.x == 0) { unsigned nloc, nx, xi; xcd_barrier_complete(b.bar, b.x, nloc, nx, xi); b.st[0] = nloc; b.st[1] = nx; b.st[3] = xi; }
}
DI void xcd_barrier(const XcdBarrier& b) {
  asm volatile("s_waitcnt vmcnt(0)" ::: "memory");
  __syncthreads();
  if (threadIdx.x == 0) {
    unsigned* bar = b.bar;
    __builtin_amdgcn_s_waitcnt(0);
    const unsigned nloc = b.st[0], nx = b.st[1];
    const unsigned old = xb_add(&bar[XB_XSUB(b.x)], 1u);
    const unsigned gen = old / nloc;
    if (old + 1u == (gen + 1u) * nloc) {
      __builtin_amdgcn_fence(__ATOMIC_RELEASE, "agent");
      asm volatile("s_waitcnt vmcnt(0)" ::: "memory");
      const unsigned og = xb_add(&bar[XB_TOP], 1u);
      const unsigned tg = og / nx;
      if (og + 1u == (tg + 1u) * nx) xb_add(&bar[XB_TOPGEN], 1u);
      else XB_SPIN(xb_ld(&bar[XB_TOPGEN]) == tg, bar);
      __builtin_amdgcn_fence(__ATOMIC_ACQUIRE, "agent");
      xb_add(&bar[XB_XGEN(b.x)], 1u);
      asm volatile("s_waitcnt vmcnt(0)" ::: "memory");
    } else {
      XB_SPIN(xb_ld(&bar[XB_XGEN(b.x)]) == gen, bar);
      __builtin_amdgcn_fence(__ATOMIC_ACQUIRE, "agent");
      asm volatile("s_waitcnt vmcnt(0)" ::: "memory");
    }
  }
  __syncthreads();
}

DI void xcd_local_barrier(const XcdBarrier& b) {
  asm volatile("s_waitcnt vmcnt(0)" ::: "memory");
  __syncthreads();
  if (threadIdx.x == 0) {
    unsigned* bar = b.bar;
    __builtin_amdgcn_s_waitcnt(0);
    const unsigned nloc = b.st[0];
    const unsigned old = xb_add(&bar[XB_LSUB(b.x)], 1u);
    const unsigned gen = old / nloc;
    if (old + 1u == (gen + 1u) * nloc) xb_add(&bar[XB_LGEN(b.x)], 1u);
    else XB_SPIN(xb_ld(&bar[XB_LGEN(b.x)]) == gen, bar);
    __builtin_amdgcn_fence(__ATOMIC_ACQUIRE, "agent");
    asm volatile("s_waitcnt vmcnt(0)" ::: "memory");
  }
  __syncthreads();
}

struct Sched { int xi, nx, rank, nloc; };

DI void transpose_tile(const float* __restrict__ W, bf16_t* __restrict__ out, int K, int N, int k0, int n0, const float* __restrict__ scale, float* tile) {
  const int tid = threadIdx.x;
  float tv[16];
#pragma unroll
  for (int i = 0; i < 16; ++i) {
    const int kk = i * 4 + (tid >> 6), nn = tid & 63, n = n0 + nn;
    tv[i] = (n < N) ? W[(size_t)(k0 + kk) * N + n] : 0.f;
  }
#pragma unroll
  for (int i = 0; i < 16; ++i) {
    const int kk = i * 4 + (tid >> 6), nn = tid & 63;
    float v = tv[i];
    if (scale) v *= scale[k0 + kk];
    tile[kk * 65 + nn] = v;
  }
  __syncthreads();
#pragma unroll
  for (int i = 0; i < 2; ++i) {
    const int nn = i * 32 + (tid >> 3), kk8 = (tid & 7) * 8;
    u32x4 w;
#pragma unroll
    for (int e = 0; e < 4; ++e) w[e] = pk_bf16(tile[(kk8 + 2 * e) * 65 + nn], tile[(kk8 + 2 * e + 1) * 65 + nn]);
    *(u32x4*)(out + (size_t)(n0 + nn) * K + k0 + kk8) = w;
  }
  __syncthreads();
}

DI void ada_item(const Params& p, float* red, int item) {
  const int tid = threadIdx.x, col = tid & 15, ks = tid >> 4, n = item * 16 + col;
  float a0 = 0.f, a1 = 0.f;
#pragma unroll
  for (int kq = 0; kq < 2; ++kq) {
    float wv[32];
#pragma unroll
    for (int j = 0; j < 32; ++j) wv[j] = p.w_ada[(size_t)(ks * 64 + kq * 32 + j) * 3072 + n];
#pragma unroll
    for (int j = 0; j < 32; ++j) {
      const int k = ks * 64 + kq * 32 + j;
      const float c0 = p.c[k], c1 = p.c[1024 + k];
      a0 += (c0 / (1.f + __expf(-c0))) * wv[j];
      a1 += (c1 / (1.f + __expf(-c1))) * wv[j];
    }
  }
  red[(ks * 16 + col) * 2 + 0] = a0;
  red[(ks * 16 + col) * 2 + 1] = a1;
  __syncthreads();
  if (tid < 32) {
    const int cc = tid & 15, b = tid >> 4;
    float s = 0.f;
    for (int q = 0; q < 16; ++q) s += red[(q * 16 + cc) * 2 + b];
    p.ada[b * 3072 + item * 16 + cc] = s + p.b_ada[item * 16 + cc];
  }
  __syncthreads();
}

DI void rope_item(const Params& p, int item) {
  const int idx = item * 256 + threadIdx.x, token = idx >> 4, j = idx & 15;
  const float ang = (float)p.pos[token] * kInvFreq[j];
  const double a = (double)ang;
  const double n = rint(a * 0.6366197723675814);
  double r = fma(-n, 1.5707963267948966, a);
  r = fma(-n, 6.123233995736766e-17, r);
  const int q = ((int)n) & 3;
  const double r2 = r * r;
  const double sn = r * (1.0 + r2 * (-1.0 / 6 + r2 * (1.0 / 120 + r2 * (-1.0 / 5040 + r2 * (1.0 / 362880 + r2 * (-1.0 / 39916800))))));
  const double cs = 1.0 + r2 * (-0.5 + r2 * (1.0 / 24 + r2 * (-1.0 / 720 + r2 * (1.0 / 40320 + r2 * (-1.0 / 3628800 + r2 * (1.0 / 479001600))))));
  double co, si;
  if (q == 0) { co = cs; si = sn; } else if (q == 1) { co = -sn; si = cs; } else if (q == 2) { co = -cs; si = -sn; } else { co = sn; si = -cs; }
  p.cosT[idx] = (float)co;
  p.sinT[idx] = (float)si;
}

DI void phase0(const Params& p, char* smem, int bid, int nb) {
  constexpr int N_ADA = 192, N_TIN = 16 * 52, N_TUQ = 6 * 12, N_TUKV = 4 * 16, N_TOUT = 16 * 16, N_ROPE = 1024;
  constexpr int TOTAL = N_ADA + N_TIN + N_TUQ + N_TUKV + N_TOUT + N_ROPE;
  float* tile = (float*)smem;
  for (int it = bid; it < TOTAL; it += nb) {
    int i = it;
    if (i < N_ADA) { ada_item(p, tile, i); continue; }
    i -= N_ADA;
    if (i < N_TIN) { transpose_tile(p.w_in, p.WinT, 1024, INC, (i / 52) * 64, (i % 52) * 64, nullptr, tile); continue; }
    i -= N_TIN;
    if (i < N_TUQ) { transpose_tile(p.w_uq, p.WuqT, 384, 768, (i / 12) * 64, (i % 12) * 64, p.qln, tile); continue; }
    i -= N_TUQ;
    if (i < N_TUKV) { transpose_tile(p.w_ukv, p.WukvT, 256, 1024, (i / 16) * 64, (i % 16) * 64, p.kvln, tile); continue; }
    i -= N_TUKV;
    if (i < N_TOUT) { transpose_tile(p.w_out, p.WoutT, 1024, 1024, (i / 16) * 64, (i % 16) * 64, nullptr, tile); continue; }
    i -= N_TOUT;
    rope_item(p, i);
  }
}

DI void phase1(const Params& p, const Sched sc) {
  const int tid = threadIdx.x, lane = tid & 63, wave = tid >> 6;
  for (int v = sc.xi; v < 8; v += sc.nx)
  for (int l = sc.rank; l < 128; l += sc.nloc) {
    const int rowa = v * 2048 + l * 16 + wave * 4, b = rowa >> 13;
    f32x4 v4[4][4];
#pragma unroll
    for (int q = 0; q < 4; ++q) {
      const f32x4* xr = (const f32x4*)(p.x + (size_t)(rowa + q) * DM);
#pragma unroll
      for (int i = 0; i < 2; ++i) { v4[q][2 * i] = xr[2 * lane + 128 * i]; v4[q][2 * i + 1] = xr[2 * lane + 128 * i + 1]; }
    }
    const float* ad = p.ada + b * 3072;
    f32x4 nw[4], sh[4];
#pragma unroll
    for (int j = 0; j < 4; ++j) {
      const int k = (2 * lane + 128 * (j >> 1) + (j & 1)) * 4;
      nw[j] = *(const f32x4*)(p.norm_w + k); sh[j] = *(const f32x4*)(ad + k);
      const f32x4 sc4 = *(const f32x4*)(ad + 1024 + k);
#pragma unroll
      for (int e = 0; e < 4; ++e) nw[j][e] *= 1.f + sc4[e];
    }
#pragma unroll
    for (int q = 0; q < 4; ++q) {
      float ss = 0.f;
#pragma unroll
      for (int j = 0; j < 4; ++j) ss += v4[q][j][0] * v4[q][j][0] + v4[q][j][1] * v4[q][j][1] + v4[q][j][2] * v4[q][j][2] + v4[q][j][3] * v4[q][j][3];
#pragma unroll
      for (int o = 1; o < 64; o <<= 1) ss += __shfl_xor(ss, o);
      const float rstd = rsqrtf(ss * (1.f / DM) + 1e-6f);
#pragma unroll
      for (int i = 0; i < 2; ++i) {
        u32x4 w;
#pragma unroll
        for (int jj = 0; jj < 2; ++jj) {
          const int j = 2 * i + jj;
          float o[4];
#pragma unroll
          for (int e = 0; e < 4; ++e) o[e] = (v4[q][j][e] * rstd) * nw[j][e] + sh[j][e];
          w[2 * jj] = pk_bf16(o[0], o[1]); w[2 * jj + 1] = pk_bf16(o[2], o[3]);
        }
        *(u32x4*)(p.H + (size_t)(rowa + q) * DM + (2 * lane + 128 * i) * 4) = w;
      }
    }
  }
}

template <int RM, int CN, int WR, int WC, bool SUMSQ, int BK = 64, bool FDB = false>
DI void gemm_tile_core(const bf16_t* __restrict__ Rg, int ldr, const bf16_t* __restrict__ Cg, int ldc, int K, char* smem,
                       f32x16 (&acc)[RM / WR / 32][CN / WC / 32], float* sumsq,
                       u32x4 (&rr)[2][RM * BK / 2048], u32x4 (&cr)[2][CN * BK / 2048], long dR, long dC, bool cold) {
  constexpr int MI = RM / WR / 32, NI = CN / WC / 32, STR = BK + 8, CPR = BK / 8, RPP = 256 / CPR, KS = BK / 16;
  constexpr int RCH = RM / RPP, CCH = CN / RPP, BUFE = (RM + CN) * STR;
  bf16_t* lds = (bf16_t*)smem;
  const int tid = threadIdx.x, lane = tid & 63, wave = tid >> 6, r = lane & 31, h = lane >> 5;
  const int wr = wave / WC, wc = wave % WC;
  const int srow = tid / CPR, skc = (tid % CPR) * 8;
  float ss[CCH];
#pragma unroll
  for (int i = 0; i < CCH; ++i) ss[i] = 0.f;
#pragma unroll
  for (int mi = 0; mi < MI; ++mi)
#pragma unroll
    for (int ni = 0; ni < NI; ++ni)
#pragma unroll
      for (int i = 0; i < 16; ++i) acc[mi][ni][i] = 0.f;
  const bf16_t* rp = Rg + (size_t)srow * ldr + skc;
  const bf16_t* cp = Cg + (size_t)srow * ldc + skc;
  const int nk = K / BK;
#define GT_LOAD(SET, KT) { const int k0_ = (KT) * BK; \
    _Pragma("unroll") for (int i = 0; i < RCH; ++i) rr[SET][i] = *(const u32x4*)(rp + (size_t)(RPP * i) * ldr + k0_); \
    _Pragma("unroll") for (int i = 0; i < CCH; ++i) cr[SET][i] = *(const u32x4*)(cp + (size_t)(RPP * i) * ldc + k0_); \
    __builtin_amdgcn_sched_barrier(0); }
#define GT_WRITE(SET, BUF, COUNT) { \
    _Pragma("unroll") for (int i = 0; i < RCH; ++i) *(u32x4*)((BUF) + (srow + RPP * i) * STR + skc) = rr[SET][i]; \
    _Pragma("unroll") for (int i = 0; i < CCH; ++i) *(u32x4*)((BUF) + (RM + srow + RPP * i) * STR + skc) = cr[SET][i]; \
    if (SUMSQ && (COUNT)) { _Pragma("unroll") for (int i = 0; i < CCH; ++i) { _Pragma("unroll") for (int e = 0; e < 4; ++e) { const float a_ = bf_lo(cr[SET][i][e]), b_ = bf_hi(cr[SET][i][e]); ss[i] += a_ * a_ + b_ * b_; } } } }
  if (cold) {
    GT_LOAD(0, 0)
    GT_LOAD(1, 1)
    GT_WRITE(0, lds, true)
    GT_LOAD(0, (2 < nk) ? 2 : nk - 1)
    __syncthreads();
  }
  for (int kt2 = 0; kt2 < nk; kt2 += 2) {
#pragma unroll
    for (int st = 0; st < 2; ++st) {
      const int kt = kt2 + st;
      const bf16_t* cur = lds + st * BUFE;
      bf16_t* oth = lds + (st ^ 1) * BUFE;
      const long k0r = (kt + 3 < nk) ? (long)(kt + 3) * BK : dR + (long)(kt + 3 - nk) * BK;
      const long k0c = (kt + 3 < nk) ? (long)(kt + 3) * BK : dC + (long)(kt + 3 - nk) * BK;
      const bool cnt = kt + 1 < nk;
      const bf16_t* abase = cur + (wr * (RM / WR) + r) * STR + h * 8;
      const bf16_t* bbase = cur + (RM + wc * (CN / WC) + r) * STR + h * 8;
      bf16x8 af[2][MI], bfr[2][NI];
      if (FDB) {
#pragma unroll
        for (int mi = 0; mi < MI; ++mi) af[0][mi] = *(const bf16x8*)(abase + mi * 32 * STR);
#pragma unroll
        for (int ni = 0; ni < NI; ++ni) bfr[0][ni] = *(const bf16x8*)(bbase + ni * 32 * STR);
      }
#pragma unroll
      for (int ks = 0; ks < KS; ++ks) {
        if (FDB && ks + 1 < KS) {
#pragma unroll
          for (int mi = 0; mi < MI; ++mi) af[(ks + 1) & 1][mi] = *(const bf16x8*)(abase + mi * 32 * STR + (ks + 1) * 16);
#pragma unroll
          for (int ni = 0; ni < NI; ++ni) bfr[(ks + 1) & 1][ni] = *(const bf16x8*)(bbase + ni * 32 * STR + (ks + 1) * 16);
        }
        if (!FDB) {
#pragma unroll
          for (int mi = 0; mi < MI; ++mi) af[ks & 1][mi] = *(const bf16x8*)(abase + mi * 32 * STR + ks * 16);
#pragma unroll
          for (int ni = 0; ni < NI; ++ni) bfr[ks & 1][ni] = *(const bf16x8*)(bbase + ni * 32 * STR + ks * 16);
        }
#pragma unroll
        for (int c = ks; c < RCH; c += KS) *(u32x4*)(oth + (srow + RPP * c) * STR + skc) = rr[st ^ 1][c];
#pragma unroll
        for (int c = ks; c < CCH; c += KS) {
          *(u32x4*)(oth + (RM + srow + RPP * c) * STR + skc) = cr[st ^ 1][c];
          if (SUMSQ && cnt) {
#pragma unroll
            for (int e = 0; e < 4; ++e) { const float a_ = bf_lo(cr[st ^ 1][c][e]), b_ = bf_hi(cr[st ^ 1][c][e]); ss[c] += a_ * a_ + b_ * b_; }
          }
        }
#pragma unroll
        for (int c = ks; c < RCH; c += KS) rr[st ^ 1][c] = *(const u32x4*)(rp + (size_t)(RPP * c) * ldr + k0r);
#pragma unroll
        for (int c = ks; c < CCH; c += KS) cr[st ^ 1][c] = *(const u32x4*)(cp + (size_t)(RPP * c) * ldc + k0c);
        __builtin_amdgcn_sched_barrier(0);
#pragma unroll
        for (int mi = 0; mi < MI; ++mi)
#pragma unroll
          for (int ni = 0; ni < NI; ++ni) acc[mi][ni] = MFMA32(af[ks & 1][mi], bfr[ks & 1][ni], acc[mi][ni]);
      }
      __syncthreads();
    }
  }
#undef GT_LOAD
#undef GT_WRITE
  if (SUMSQ) {
#pragma unroll
    for (int i = 0; i < CCH; ++i) {
      float s = ss[i];
      s += __shfl_xor(s, 1); s += __shfl_xor(s, 2);
      if (CPR == 8) s += __shfl_xor(s, 4);
      if ((tid % CPR) == 0) sumsq[srow + RPP * i] = s;
    }
  }
  __syncthreads();
}

template <int RM, int CN, int WR, int WC, bool SUMSQ, bool FDB = false>
DI void gemm_tile(const bf16_t* __restrict__ Rg, int ldr, const bf16_t* __restrict__ Cg, int ldc, int K, char* smem,
                  f32x16 (&acc)[RM / WR / 32][CN / WC / 32], float* sumsq) {
  u32x4 rr[2][RM / 32], cr[2][CN / 32];
  gemm_tile_core<RM, CN, WR, WC, SUMSQ, 64, FDB>(Rg, ldr, Cg, ldc, K, smem, acc, sumsq, rr, cr, 0, 0, true);
}

template <int NI>
DI void p2_store_group(const Params& p, const f32x16 (&a)[NI], int colg, int tok0, int b, int h) {
  if (colg >= INC) return;
  bf16_t* base; int stride, mode = 0, use_s = 0; float scale = 1.f;
  if (colg < 1536) {
    const int which = colg >> 9, hh = (colg & 511) >> 6, d0 = colg & 63;
    base = (which == 0 ? p.Qsb : (which == 1 ? p.Ksb : p.Vsb)) + (size_t)(b * 8 + hh) * S_ * 64 + d0; stride = 64; use_s = 1;
    if (which == 0) scale = 0.125f * LOG2E;
  } else if (colg < 2048) { base = p.Gate + (colg - 1536); stride = 1024; mode = 1; }
  else if (colg < 2432) { base = p.CQ + (colg - 2048); stride = 384; }
  else if (colg < 2688) { base = p.CKV + (colg - 2432); stride = 256; }
  else if (colg < 2720) { base = nullptr; stride = 32; mode = 2; }
  else { base = p.Gate + 512 + (colg - 2720); stride = 1024; mode = 1; }
#pragma unroll
  for (int ni = 0; ni < NI; ++ni) {
    const int token = tok0 + ni * 32;
    const int idx = use_s ? (token & (S_ - 1)) : token;
    if (mode == 2) {
      float* d = p.KR + (size_t)token * 32 + 4 * h;
#pragma unroll
      for (int g = 0; g < 4; ++g) { f32x4 v = {a[ni][4 * g], a[ni][4 * g + 1], a[ni][4 * g + 2], a[ni][4 * g + 3]}; *(f32x4*)(d + 8 * g) = v; }
    } else {
      bf16_t* d = base + (size_t)idx * stride + 8 * h;
#pragma unroll
      for (int q = 0; q < 2; ++q) {
        u32x2 w[2];
#pragma unroll
        for (int gg = 0; gg < 2; ++gg) {
          const int g = 2 * q + gg;
          float v0 = a[ni][4 * g] * scale, v1 = a[ni][4 * g + 1] * scale, v2 = a[ni][4 * g + 2] * scale, v3 = a[ni][4 * g + 3] * scale;
          if (mode == 1) { v0 = silu_f(v0); v1 = silu_f(v1); v2 = silu_f(v2); v3 = silu_f(v3); }
          w[gg].x = pk_bf16(v0, v1); w[gg].y = pk_bf16(v2, v3);
        }
        *(u32x4*)(d + 16 * q) = widen_pair(w[0], w[1]);
        __builtin_amdgcn_sched_barrier(0);
      }
    }
  }
}

DI void phase2(const Params& p, char* smem, const Sched sc) {
  const int tid = threadIdx.x, lane = tid & 63, wave = tid >> 6, r = lane & 31, h = lane >> 5, wr = wave >> 1, wc = wave & 1;
  constexpr int NFULL = 384, NLIST = 16 * 26;
  u32x4 rr[2][4], cr[2][4];
  for (int v = sc.xi; v < 8; v += sc.nx) {
    bool cold = true;
    for (int l = sc.rank; l < NFULL; l += sc.nloc) {
      const int g8 = l / (8 * 26), rem = l % (8 * 26), nt = rem >> 3, mt = 16 * v + 8 * g8 + (rem & 7), m0 = mt * 128, n0 = nt * 128;
      const int l2 = l + sc.nloc;
      long dR = 0, dC = 0;
      if (l2 < NFULL) {
        const int g8n = l2 / (8 * 26), remn = l2 % (8 * 26), ntn = remn >> 3, mtn = 16 * v + 8 * g8n + (remn & 7);
        dR = (long)(ntn * 128 - n0) * DM; dC = (long)(mtn * 128 - m0) * DM;
      }
      f32x16 acc[2][2];
      gemm_tile_core<128, 128, 2, 2, false, 64, true>(p.WinT + (size_t)n0 * DM, DM, p.H + (size_t)m0 * DM, DM, DM, smem, acc, nullptr, rr, cr, dR, dC, cold);
      cold = false;
#pragma unroll
      for (int mi = 0; mi < 2; ++mi) p2_store_group<2>(p, acc[mi], n0 + wr * 64 + mi * 32, m0 + wc * 64 + r, m0 >> 13, h);
    }
    for (int hl = sc.rank; hl < 2 * (NLIST - NFULL); hl += sc.nloc) {
      const int l = NFULL + (hl >> 1);
      const int g8 = l / (8 * 26), rem = l % (8 * 26), nt = rem >> 3, mt = 16 * v + 8 * g8 + (rem & 7), m0 = mt * 128, n0 = nt * 128 + 64 * (hl & 1);
      if (n0 >= INC) continue;
      f32x16 acc[2][1];
      gemm_tile<64, 128, 1, 4, false>(p.WinT + (size_t)n0 * DM, DM, p.H + (size_t)m0 * DM, DM, DM, smem, acc, nullptr);
#pragma unroll
      for (int mi = 0; mi < 2; ++mi) p2_store_group<1>(p, acc[mi], n0 + mi * 32, m0 + wave * 32 + r, m0 >> 13, h);
    }
  }
}

DI void phase3(const Params& p, char* smem, const Sched sc) {
  const int tid = threadIdx.x, lane = tid & 63, wave = tid >> 6, r = lane & 31, h = lane >> 5;
  float* sumsq = (float*)(smem + 2 * 256 * 72 * 2);
  for (int v = sc.xi; v < 8; v += sc.nx)
  for (int l = sc.rank; l < 16 * 16; l += sc.nloc) {
    const int mt = 16 * v + (l >> 4), sub = l & 15, head = sub & 7, m0 = mt * 128;
    const int tl = wave * 32 + r, token = m0 + tl, b = token >> 13, s = token & (S_ - 1);
    if (sub < 8) {
      f32x16 acc[3][1];
      gemm_tile<96, 128, 1, 4, true>(p.WuqT + (size_t)head * 96 * 384, 384, p.CQ + (size_t)m0 * 384, 384, 384, smem, acc, sumsq);
      const float rstd = rsqrtf(sumsq[tl] * (1.f / 384) + 1e-6f);
      float ssq = 0.f;
#pragma unroll
      for (int rb = 0; rb < 3; ++rb)
#pragma unroll
        for (int i = 0; i < 16; ++i) { const float v = acc[rb][0][i] * rstd; acc[rb][0][i] = v; ssq += v * v; }
      ssq += __shfl_xor(ssq, 32);
      const float r2 = rsqrtf(ssq * (1.f / 96) + 1e-6f);
#pragma unroll
      for (int rb = 0; rb < 3; ++rb)
#pragma unroll
        for (int g = 0; g < 4; ++g) {
          const f32x4 w4 = *(const f32x4*)(p.qhn + rb * 32 + 8 * g + 4 * h);
#pragma unroll
          for (int e = 0; e < 4; ++e) acc[rb][0][4 * g + e] *= r2 * w4[e];
        }
#pragma unroll
      for (int g = 0; g < 2; ++g) {
        const f32x4 c4 = *(const f32x4*)(p.cosT + (size_t)token * 16 + 8 * g + 4 * h), s4 = *(const f32x4*)(p.sinT + (size_t)token * 16 + 8 * g + 4 * h);
#pragma unroll
        for (int e = 0; e < 4; ++e) {
          const float x1 = acc[2][0][4 * g + e], x2 = acc[2][0][4 * (g + 2) + e];
          acc[2][0][4 * g + e] = x1 * c4[e] - x2 * s4[e];
          acc[2][0][4 * (g + 2) + e] = x2 * c4[e] + x1 * s4[e];
        }
      }
      const float qs = LOG2E * 0.10206207261596577f;
      bf16_t* dst = p.Qm + ((size_t)(b * 8 + head) * S_ + s) * 96;
#pragma unroll
      for (int rb = 0; rb < 3; ++rb) {
        u32x2 w[4];
#pragma unroll
        for (int g = 0; g < 4; ++g) { w[g].x = pk_bf16(acc[rb][0][4 * g] * qs, acc[rb][0][4 * g + 1] * qs); w[g].y = pk_bf16(acc[rb][0][4 * g + 2] * qs, acc[rb][0][4 * g + 3] * qs); }
#pragma unroll
        for (int q = 0; q < 2; ++q) *(u32x4*)(dst + rb * 32 + 16 * q + 8 * h) = widen_pair(w[2 * q], w[2 * q + 1]);
      }
    } else {
      f32x16 acc[4][1];
      gemm_tile<128, 128, 1, 4, true>(p.WukvT + (size_t)head * 128 * 256, 256, p.CKV + (size_t)m0 * 256, 256, 256, smem, acc, sumsq);
      const float rstd = rsqrtf(sumsq[tl] * (1.f / 256) + 1e-6f);
      float kr[16];
#pragma unroll
      for (int g = 0; g < 4; ++g) {
        const f32x4 k4 = *(const f32x4*)(p.KR + (size_t)token * 32 + 8 * g + 4 * h);
#pragma unroll
        for (int e = 0; e < 4; ++e) kr[4 * g + e] = k4[e];
      }
      float ssq = 0.f;
#pragma unroll
      for (int rb = 0; rb < 2; ++rb)
#pragma unroll
        for (int i = 0; i < 16; ++i) { const float v = acc[rb][0][i] * rstd; acc[rb][0][i] = v; ssq += v * v; }
#pragma unroll
      for (int i = 0; i < 16; ++i) ssq += kr[i] * kr[i];
      ssq += __shfl_xor(ssq, 32);
      const float r2 = rsqrtf(ssq * (1.f / 96) + 1e-6f);
#pragma unroll
      for (int rb = 0; rb < 2; ++rb)
#pragma unroll
        for (int g = 0; g < 4; ++g) {
          const f32x4 w4 = *(const f32x4*)(p.khn + rb * 32 + 8 * g + 4 * h);
#pragma unroll
          for (int e = 0; e < 4; ++e) acc[rb][0][4 * g + e] *= r2 * w4[e];
        }
#pragma unroll
      for (int g = 0; g < 4; ++g) {
        const f32x4 w4 = *(const f32x4*)(p.khn + 64 + 8 * g + 4 * h);
#pragma unroll
        for (int e = 0; e < 4; ++e) kr[4 * g + e] *= r2 * w4[e];
      }
#pragma unroll
      for (int g = 0; g < 2; ++g) {
        const f32x4 c4 = *(const f32x4*)(p.cosT + (size_t)token * 16 + 8 * g + 4 * h), s4 = *(const f32x4*)(p.sinT + (size_t)token * 16 + 8 * g + 4 * h);
#pragma unroll
        for (int e = 0; e < 4; ++e) {
          const float x1 = kr[4 * g + e], x2 = kr[4 * (g + 2) + e];
          kr[4 * g + e] = x1 * c4[e] - x2 * s4[e];
          kr[4 * (g + 2) + e] = x2 * c4[e] + x1 * s4[e];
        }
      }
      bf16_t* dk = p.Km + ((size_t)(b * 8 + head) * S_ + s) * 96;
      bf16_t* dv = p.Vm + ((size_t)(b * 8 + head) * S_ + s) * 64;
#pragma unroll
      for (int rb = 0; rb < 2; ++rb) {
        u32x2 w[4], u[4];
#pragma unroll
        for (int g = 0; g < 4; ++g) {
          w[g].x = pk_bf16(acc[rb][0][4 * g], acc[rb][0][4 * g + 1]); w[g].y = pk_bf16(acc[rb][0][4 * g + 2], acc[rb][0][4 * g + 3]);
          u[g].x = pk_bf16(acc[rb + 2][0][4 * g] * rstd, acc[rb + 2][0][4 * g + 1] * rstd); u[g].y = pk_bf16(acc[rb + 2][0][4 * g + 2] * rstd, acc[rb + 2][0][4 * g + 3] * rstd);
        }
#pragma unroll
        for (int q = 0; q < 2; ++q) {
          *(u32x4*)(dk + rb * 32 + 16 * q + 8 * h) = widen_pair(w[2 * q], w[2 * q + 1]);
          *(u32x4*)(dv + rb * 32 + 16 * q + 8 * h) = widen_pair(u[2 * q], u[2 * q + 1]);
        }
      }
      {
        u32x2 w[4];
#pragma unroll
        for (int g = 0; g < 4; ++g) { w[g].x = pk_bf16(kr[4 * g], kr[4 * g + 1]); w[g].y = pk_bf16(kr[4 * g + 2], kr[4 * g + 3]); }
#pragma unroll
        for (int q = 0; q < 2; ++q) *(u32x4*)(dk + 64 + 16 * q + 8 * h) = widen_pair(w[2 * q], w[2 * q + 1]);
      }
    }
  }
}

template <int DQK, bool SB, bool SMAX>
DI void attn_item(const Params& p, char* smem, int bh, int qb, float Mb) {
  constexpr int KSTR = DQK + 8, VSTR = 72, NKS = DQK / 16, KCH = DQK / 8, KPT = 64 * KCH / 256, KBUF = 64 * KSTR, VBUF = 64 * VSTR;
  bf16_t* Ks = (bf16_t*)smem;
  bf16_t* Vs = Ks + 2 * KBUF;
  int* flags = (int*)(Vs + 2 * VBUF);
  const bf16_t* Qg = SB ? p.Qsb : p.Qm;
  const bf16_t* Kg = (SB ? p.Ksb : p.Km) + (size_t)bh * S_ * DQK;
  const bf16_t* Vg = (SB ? p.Vsb : p.Vm) + (size_t)bh * S_ * 64;
  const int tid = threadIdx.x, lane = tid & 63, wave = tid >> 6, r = lane & 31, h = lane >> 5;
  const int q0 = qb * 128, qw0 = q0 + wave * 32, query = qw0 + r;
  bf16x8 qf[NKS];
  {
    const bf16_t* qp = Qg + ((size_t)bh * S_ + query) * DQK + h * 8;
#pragma unroll
    for (int ks = 0; ks < NKS; ++ks) qf[ks] = *(const bf16x8*)(qp + ks * 16);
  }
  bf16x8 tri[2], ones;
#pragma unroll
  for (int s = 0; s < 2; ++s)
#pragma unroll
    for (int j = 0; j < 8; ++j) tri[s][j] = ((16 * s + 8 * (j >> 2) + 4 * h + (j & 3)) >= r) ? (short)0x3F80 : (short)0;
#pragma unroll
  for (int j = 0; j < 8; ++j) ones[j] = (short)0x3F80;

  const int nt = 2 * (qb + 1);
  f32x16 O[2];
#pragma unroll
  for (int db = 0; db < 2; ++db)
#pragma unroll
    for (int i = 0; i < 16; ++i) O[db][i] = 0.f;
  float m = -__builtin_huge_valf(), lsum = 0.f, carry = 0.f;
  f32x16 negM;
#pragma unroll
  for (int i = 0; i < 16; ++i) negM[i] = -Mb;

  u32x4 kreg[1][KPT], vreg[1][2];
#define AT_KB(IT) (SB ? 64 * (nt - 1 - (IT)) : 64 * (IT))
#define AT_LOAD(SET, IT) { const int kl_ = AT_KB(IT); \
    _Pragma("unroll") for (int i = 0; i < KPT; ++i) kreg[SET][i] = *(const u32x4*)(Kg + (size_t)kl_ * DQK + (tid + 256 * i) * 8); \
    _Pragma("unroll") for (int i = 0; i < 2; ++i) vreg[SET][i] = *(const u32x4*)(Vg + (size_t)kl_ * 64 + (tid + 256 * i) * 8); \
    __builtin_amdgcn_sched_barrier(0); }
#define AT_WRITE(SET, BUFI) { \
    _Pragma("unroll") for (int i = 0; i < KPT; ++i) { const int c = tid + 256 * i, row = c / KCH, kcol = c % KCH; *(u32x4*)(Ks + (BUFI) * KBUF + row * KSTR + kcol * 8) = kreg[SET][i]; } \
    _Pragma("unroll") for (int i = 0; i < 2; ++i) { const int c = tid + 256 * i; *(u32x4*)(Vs + (BUFI) * VBUF + (c >> 3) * VSTR + (c & 7) * 8) = vreg[SET][i]; } }
  const int blk = (lane >> 4) & 1, tq = (lane & 15) >> 2, tp = lane & 3;
  const int voff = (4 * h + tq) * VSTR + 16 * blk + 4 * tp;

  AT_LOAD(0, 0)
  AT_WRITE(0, 0)
  AT_LOAD(0, 1)
  __syncthreads();
  bool stop = false;
  for (int it2 = 0; it2 < nt && !stop; it2 += 2) {
#pragma unroll
   for (int st2 = 0; st2 < 2; ++st2) {
    const int it = it2 + st2;
    const int kb0 = AT_KB(it);
    const bf16_t* kc = Ks + st2 * KBUF;
    const bf16_t* vc = Vs + st2 * VBUF;
    const bool active = kb0 < qw0 + 32;
    f32x16 st[2];
    if (active) {
#pragma unroll
      for (int kb = 0; kb < 2; ++kb)
#pragma unroll
        for (int i = 0; i < 16; ++i) st[kb][i] = SMAX ? negM[i] : 0.f;
#pragma unroll
      for (int ks = 0; ks < NKS; ++ks)
#pragma unroll
        for (int kb = 0; kb < 2; ++kb) {
          const bf16x8 a = *(const bf16x8*)(kc + (kb * 32 + r) * KSTR + ks * 16 + h * 8);
          st[kb] = MFMA32(a, qf[ks], st[kb]);
        }
    }
    __builtin_amdgcn_sched_barrier(0);
    AT_WRITE(0, st2 ^ 1)
    AT_LOAD(0, (it + 2 < nt) ? it + 2 : nt - 1)
    if (active) {
      const bool diag = (kb0 + 64 > qw0);
      bf16x8 pk[4];
      if (!SB) {
        if (diag) {
#pragma unroll
          for (int kb = 0; kb < 2; ++kb)
#pragma unroll
            for (int i = 0; i < 16; ++i) { const int key = kb0 + kb * 32 + crow(i, h); if (key > query) st[kb][i] = -__builtin_huge_valf(); }
        }
        if (SMAX) {
          float ps = 0.f;
#pragma unroll
          for (int kb = 0; kb < 2; ++kb)
#pragma unroll
            for (int i = 0; i < 16; ++i) { const float pv = fast_exp2(st[kb][i]); st[kb][i] = pv; ps += pv; }
          lsum += ps;
        } else {
        float mx = st[0][0];
#pragma unroll
        for (int kb = 0; kb < 2; ++kb)
#pragma unroll
          for (int i = 0; i < 16; ++i) mx = fmaxf(mx, st[kb][i]);
        mx = fmaxf(mx, __shfl_xor(mx, 32));
        const float mnew = fmaxf(m, mx);
        const float alpha = fast_exp2(m - mnew);
        m = mnew;
        float ps = 0.f;
#pragma unroll
        for (int kb = 0; kb < 2; ++kb)
#pragma unroll
          for (int i = 0; i < 16; ++i) { const float pv = fast_exp2(st[kb][i] - mnew); st[kb][i] = pv; ps += pv; }
        lsum = lsum * alpha + ps;
#pragma unroll
        for (int db = 0; db < 2; ++db)
#pragma unroll
          for (int i = 0; i < 16; ++i) O[db][i] *= alpha;
        }
      } else {
        f32x16 ca[2];
        bf16x8 hi[4], lo[4];
        float tsum = 0.f;
#pragma unroll
        for (int kb = 0; kb < 2; ++kb)
#pragma unroll
          for (int i2 = 0; i2 < 8; ++i2) {
            float lk[2];
#pragma unroll
            for (int e = 0; e < 2; ++e) {
              const int i = 2 * i2 + e;
              const float z = fminf(st[kb][i], 100.f);
              const int key = kb0 + kb * 32 + crow(i, h);
              const bool valid = !diag || (key < query);
              float l = -fast_log2(1.f + fast_exp2(z));
              l = valid ? l : 0.f;
              lk[e] = l;
              tsum += l;
              ca[kb][i] = z + carry;
            }
            const unsigned hp = pk_bf16(lk[0], lk[1]);
            const unsigned lp = pk_bf16(lk[0] - bf_lo(hp), lk[1] - bf_hi(hp));
            const int kk = kb * 2 + (i2 >> 2), w = i2 & 3;
            hi[kk][2 * w] = (short)(hp & 0xffffu); hi[kk][2 * w + 1] = (short)(hp >> 16);
            lo[kk][2 * w] = (short)(lp & 0xffffu); lo[kk][2 * w + 1] = (short)(lp >> 16);
          }
        tsum += __shfl_xor(tsum, 32);
#pragma unroll
        for (int s = 0; s < 2; ++s) {
          ca[0] = MFMA32(tri[s], hi[s], ca[0]);
          ca[0] = MFMA32(tri[s], lo[s], ca[0]);
          ca[0] = MFMA32(ones, hi[2 + s], ca[0]);
          ca[0] = MFMA32(ones, lo[2 + s], ca[0]);
          ca[1] = MFMA32(tri[s], hi[2 + s], ca[1]);
          ca[1] = MFMA32(tri[s], lo[2 + s], ca[1]);
        }
#pragma unroll
        for (int kb = 0; kb < 2; ++kb)
#pragma unroll
          for (int i = 0; i < 16; ++i) {
            const int key = kb0 + kb * 32 + crow(i, h);
            const bool valid = !diag || (key < query);
            st[kb][i] = valid ? fast_exp2(ca[kb][i]) : 0.f;
          }
        carry += tsum;
      }
#pragma unroll
      for (int kb = 0; kb < 2; ++kb)
#pragma unroll
        for (int s = 0; s < 2; ++s) {
          u32x4 w;
#pragma unroll
          for (int e = 0; e < 4; ++e) w[e] = pk_bf16(st[kb][8 * s + 2 * e], st[kb][8 * s + 2 * e + 1]);
          pk[kb * 2 + s] = __builtin_bit_cast(bf16x8, w);
        }
#pragma unroll
      for (int kk = 0; kk < 4; ++kk)
#pragma unroll
        for (int db = 0; db < 2; ++db) {
          const s16x4 v0 = __builtin_amdgcn_ds_read_tr16_b64_v4i16((lds_s16x4*)(vc + voff + (16 * kk) * VSTR + 32 * db));
          const s16x4 v1 = __builtin_amdgcn_ds_read_tr16_b64_v4i16((lds_s16x4*)(vc + voff + (16 * kk + 8) * VSTR + 32 * db));
          const bf16x8 vf = __builtin_shufflevector(v0, v1, 0, 1, 2, 3, 4, 5, 6, 7);
          O[db] = MFMA32(vf, pk[kk], O[db]);
        }
    }
    if (SB) {
      const bool alive = __builtin_amdgcn_ballot_w64(carry > -64.f) != 0ull;
      if (lane == 0) flags[st2 * 4 + wave] = alive ? 1 : 0;
    }
    __syncthreads();
    if (SB) {
      const int any = flags[st2 * 4 + 0] | flags[st2 * 4 + 1] | flags[st2 * 4 + 2] | flags[st2 * 4 + 3];
      if (!any) { stop = true; break; }
    }
   }
  }
#undef AT_KB
#undef AT_LOAD
#undef AT_WRITE
  float inv = 1.f;
  if (!SB) { const float lt = lsum + __shfl_xor(lsum, 32); inv = 1.f / lt; }
  const size_t token = (size_t)(bh >> 3) * S_ + query;
  const int colbase = (SB ? 0 : 512) + (bh & 7) * 64;
#pragma unroll
  for (int db = 0; db < 2; ++db) {
    u32x2 w[4];
#pragma unroll
    for (int g = 0; g < 4; ++g) {
      const int col = colbase + db * 32 + 8 * g + 4 * h;
      const u32x2 gt = *(const u32x2*)(p.Gate + token * 1024 + col);
      w[g].x = pk_bf16(O[db][4 * g] * inv * bf_lo(gt.x), O[db][4 * g + 1] * inv * bf_hi(gt.x));
      w[g].y = pk_bf16(O[db][4 * g + 2] * inv * bf_lo(gt.y), O[db][4 * g + 3] * inv * bf_hi(gt.y));
    }
#pragma unroll
    for (int q = 0; q < 2; ++q) *(u32x4*)(p.Mixed + token * 1024 + colbase + db * 32 + 16 * q + 8 * h) = widen_pair(w[2 * q], w[2 * q + 1]);
  }
  __syncthreads();
}

DI void phase4(const Params& p, char* smem, const Sched sc) {
  int* s_item = (int*)(smem + LDS_BYTES - 16);
  float gq = 0.f, gk = 0.f;
  for (int i = 0; i < 96; ++i) { gq = fmaxf(gq, fabsf(p.qhn[i])); gk = fmaxf(gk, fabsf(p.khn[i])); }
  const float Mb = LOG2E * 9.797958971132712f * gq * gk * 1.02f;
  const bool smax = Mb < 56.f;
  for (int v = sc.xi; v < 8; v += sc.nx)
  for (;;) {
    if (threadIdx.x == 0) *s_item = (int)atomicAdd(&p.counters[XB_WQ(v)], 1u);
    __syncthreads();
    const int item = *s_item;
    __syncthreads();
    if (item >= 256) break;
    if (item < 128) {
      const int bh = 2 * v + (item & 1), qb = 63 - (item >> 1);
      if (smax) attn_item<96, false, true>(p, smem, bh, qb, Mb);
      else attn_item<96, false, false>(p, smem, bh, qb, 0.f);
    } else { const int j = item - 128; attn_item<64, true, false>(p, smem, 2 * v + (j & 1), 63 - (j >> 1), 0.f); }
  }
}

DI void phase5(const Params& p, char* smem, const Sched sc) {
  const int tid = threadIdx.x, lane = tid & 63, wave = tid >> 6, r = lane & 31, h = lane >> 5, wr = wave >> 1, wc = wave & 1;
  constexpr int CST = 132;
  float* ct = (float*)smem;
  for (int v = sc.xi; v < 8; v += sc.nx)
  for (int l = sc.rank; l < 16 * 8; l += sc.nloc) {
    const int g8 = l >> 6, rem = l & 63, nt = rem >> 3, mt = 16 * v + 8 * g8 + (rem & 7), m0 = mt * 128, n0 = nt * 128;
    f32x16 acc[2][2];
    gemm_tile<128, 128, 2, 2, false, true>(p.WoutT + (size_t)n0 * DM, DM, p.Mixed + (size_t)m0 * DM, DM, DM, smem, acc, nullptr);
    const int b = m0 >> 13;
#pragma unroll
    for (int mi = 0; mi < 2; ++mi)
#pragma unroll
      for (int ni = 0; ni < 2; ++ni)
#pragma unroll
        for (int g = 0; g < 4; ++g) {
          const f32x4 vv = {acc[mi][ni][4 * g], acc[mi][ni][4 * g + 1], acc[mi][ni][4 * g + 2], acc[mi][ni][4 * g + 3]};
          *(f32x4*)(ct + (wc * 64 + ni * 32 + r) * CST + wr * 64 + mi * 32 + 8 * g + 4 * h) = vv;
        }
    __syncthreads();
    const int c4 = (tid & 31) * 4, row0 = tid >> 5;
    const f32x4 gt = *(const f32x4*)(p.ada + b * 3072 + 2048 + n0 + c4);
#pragma unroll
    for (int half = 0; half < 2; ++half) {
      f32x4 xv[8];
#pragma unroll
      for (int j = 0; j < 8; ++j) xv[j] = *(const f32x4*)(p.x + (size_t)(m0 + row0 + 8 * (half * 8 + j)) * DM + n0 + c4);
#pragma unroll
      for (int j = 0; j < 8; ++j) {
        const int row = row0 + 8 * (half * 8 + j);
        const f32x4 cv = *(const f32x4*)(ct + row * CST + c4);
        f32x4 o;
#pragma unroll
        for (int e = 0; e < 4; ++e) o[e] = xv[j][e] + gt[e] * cv[e];
        *(f32x4*)(p.out + (size_t)(m0 + row) * DM + n0 + c4) = o;
      }
    }
    __syncthreads();
  }
}

#if !ONE_LAUNCH
template <int PH>
__global__ void __launch_bounds__(256, 2) k_phase(Params p) {
  __shared__ __attribute__((aligned(16))) char smem[LDS_BYTES];
  const int bid = blockIdx.x, nb = gridDim.x;
  Sched sc; sc.xi = bid & 7; sc.nx = 8; sc.rank = bid >> 3; sc.nloc = nb >> 3;
  if (PH == 0) phase0(p, smem, bid, nb);
  if (PH == 1) phase1(p, sc);
  if (PH == 2) phase2(p, smem, sc);
  if (PH == 3) phase3(p, smem, sc);
  if (PH == 4) phase4(p, smem, sc);
  if (PH == 5) phase5(p, smem, sc);
}

#else
__global__ void __launch_bounds__(256, 2) k_mega(Params p) {
  __shared__ __attribute__((aligned(16))) char smem[LDS_BYTES];
  __shared__ uint4 xb_words;
  if (p.out == nullptr) cg::this_grid().sync();
  const int bid = blockIdx.x, nb = gridDim.x;
  if (threadIdx.x == 0) xb_words = make_uint4(0u, 0u, 0u, 0u);
  __syncthreads();
  const XcdBarrier xb = xcd_barrier_post(p.counters, (volatile LAS unsigned*)&xb_words);
  phase0(p, smem, bid, nb);
  xcd_census(xb);
  xcd_barrier(xb);
  Sched sc; sc.nloc = (int)xb_words.x; sc.nx = (int)xb_words.y; sc.rank = (int)xb_words.z; sc.xi = (int)xb_words.w;
  if (__builtin_amdgcn_readfirstlane(sc.rank) * 2 >= __builtin_amdgcn_readfirstlane(sc.nloc)) __builtin_amdgcn_s_setprio(1);
  phase1(p, sc);
  xcd_local_barrier(xb);
  phase2(p, smem, sc);
  xcd_local_barrier(xb);
  phase3(p, smem, sc);
  xcd_barrier(xb);
  phase4(p, smem, sc);
  xcd_barrier(xb);
  phase5(p, smem, sc);
}

#endif

extern "C" void kernel_launch(void* const* d_in, const int* in_sizes, int n_in, void* d_out, int out_size, void* d_ws, size_t ws_size, hipStream_t stream) {
  Params p{};
  p.x = (const float*)d_in[0]; p.c = (const float*)d_in[1]; p.pos = (const int*)d_in[2];
  p.w_ada = (const float*)d_in[3]; p.b_ada = (const float*)d_in[4]; p.norm_w = (const float*)d_in[5]; p.w_in = (const float*)d_in[6];
  p.qln = (const float*)d_in[7]; p.w_uq = (const float*)d_in[8]; p.kvln = (const float*)d_in[9]; p.w_ukv = (const float*)d_in[10];
  p.qhn = (const float*)d_in[11]; p.khn = (const float*)d_in[12]; p.w_out = (const float*)d_in[13];
  p.out = (float*)d_out;
  char* w = (char*)d_ws;
  size_t off = 0;
  auto take = [&](size_t bytes) { char* q = w + off; off += (bytes + 255) & ~(size_t)255; return q; };
  p.ada = (float*)take(2 * 3072 * 4);
  p.counters = (unsigned*)take(XB_TOTAL_WORDS * 4);
  p.cosT = (float*)take((size_t)NTOK * 16 * 4);
  p.sinT = (float*)take((size_t)NTOK * 16 * 4);
  p.WinT = (bf16_t*)take((size_t)INPAD * 1024 * 2);
  p.WuqT = (bf16_t*)take((size_t)768 * 384 * 2);
  p.WukvT = (bf16_t*)take((size_t)1024 * 256 * 2);
  p.WoutT = (bf16_t*)take((size_t)1024 * 1024 * 2);
  p.H = (bf16_t*)take((size_t)NTOK * 1024 * 2);
  p.Qsb = (bf16_t*)take((size_t)NTOK * 512 * 2);
  p.Ksb = (bf16_t*)take((size_t)NTOK * 512 * 2);
  p.Vsb = (bf16_t*)take((size_t)NTOK * 512 * 2);
  p.Gate = (bf16_t*)take((size_t)NTOK * 1024 * 2);
  p.CQ = (bf16_t*)take((size_t)NTOK * 384 * 2);
  p.CKV = (bf16_t*)take((size_t)NTOK * 256 * 2);
  p.KR = (float*)take((size_t)NTOK * 32 * 4);
  p.Qm = (bf16_t*)take((size_t)NTOK * 768 * 2);
  p.Km = (bf16_t*)take((size_t)NTOK * 768 * 2);
  p.Vm = (bf16_t*)take((size_t)NTOK * 512 * 2);
  p.Mixed = p.H;
  hipMemsetAsync(p.counters, 0, XB_TOTAL_WORDS * 4, stream);
#if ONE_LAUNCH
  static int grid_blocks = 0;
  if (!grid_blocks) {
    int dev = 0, cus = 0, per_cu = 0;
    hipGetDevice(&dev);
    hipDeviceGetAttribute(&cus, hipDeviceAttributeMultiprocessorCount, dev);
    hipOccupancyMaxActiveBlocksPerMultiprocessor(&per_cu, k_mega, 256, 0);
    if (per_cu > 2) per_cu = 2;
    if (per_cu < 1) per_cu = 1;
    grid_blocks = cus * per_cu;
  }
  void* args[] = {&p};
  hipError_t e = hipLaunchCooperativeKernel((void*)k_mega, dim3(grid_blocks), dim3(256), args, 0, stream);
  if (e != hipSuccess) fprintf(stderr, "cooperative launch failed: %s (grid %d)\n", hipGetErrorString(e), grid_blocks);
#else
  const int G = 512;
#ifndef DUP_PHASE
#define DUP_PHASE -1
#endif
  k_phase<0><<<G, 256, 0, stream>>>(p);
  if (DUP_PHASE == 0) k_phase<0><<<G, 256, 0, stream>>>(p);
  k_phase<1><<<G, 256, 0, stream>>>(p);
  if (DUP_PHASE == 1) k_phase<1><<<G, 256, 0, stream>>>(p);
  k_phase<2><<<G, 256, 0, stream>>>(p);
  if (DUP_PHASE == 2) k_phase<2><<<G, 256, 0, stream>>>(p);
  k_phase<3><<<G, 256, 0, stream>>>(p);
  if (DUP_PHASE == 3) k_phase<3><<<G, 256, 0, stream>>>(p);
  k_phase<4><<<G, 256, 0, stream>>>(p);
  if (DUP_PHASE == 4) { hipMemsetAsync(p.counters, 0, XB_TOTAL_WORDS * 4, stream); k_phase<4><<<G, 256, 0, stream>>>(p); }
  k_phase<5><<<G, 256, 0, stream>>>(p);
  if (DUP_PHASE == 5) k_phase<5><<<G, 256, 0, stream>>>(p);
#endif
}
```

```cpp
#include <hip/hip_runtime.h>
#include <hip/hip_cooperative_groups.h>
#include <cstdio>
#include <cstdint>
namespace cg = cooperative_groups;

#ifndef ONE_LAUNCH
#define ONE_LAUNCH 1
#endif

typedef unsigned short bf16_t;
typedef short bf16x8 __attribute__((ext_vector_type(8)));
typedef short s16x4 __attribute__((ext_vector_type(4)));
typedef float f32x16 __attribute__((ext_vector_type(16)));
typedef float f32x4 __attribute__((ext_vector_type(4)));
typedef float f32x2 __attribute__((ext_vector_type(2)));
typedef __bf16 bf2_t __attribute__((ext_vector_type(2)));
typedef unsigned u32x4 __attribute__((ext_vector_type(4)));
typedef unsigned u32x2 __attribute__((ext_vector_type(2)));
typedef __attribute__((address_space(3))) s16x4 lds_s16x4;

#define DI __device__ __forceinline__
#define MFMA32(a, b, c) __builtin_amdgcn_mfma_f32_32x32x16_bf16((a), (b), (c), 0, 0, 0)

constexpr int S_ = 8192, NTOK = 16384, DM = 1024, INC = 3232, INPAD = 3328;
constexpr float LOG2E = 1.4426950408889634f;
constexpr int LDS_BYTES = 2 * 256 * 72 * 2 + 1024;

__device__ const float kInvFreq[16] = {1.0f, 0.5623413324356079f, 0.3162277638912201f, 0.17782793939113617f, 0.10000000149011612f, 0.05623413249850273f, 0.03162277489900589f, 0.017782794311642647f, 0.009999999776482582f, 0.005623413249850273f, 0.003162277629598975f, 0.0017782794311642647f, 0.0010000000474974513f, 0.000562341301701963f, 0.0003162277571391314f, 0.00017782794020604342f};

struct Params {
  const float *x, *c; const int* pos; const float *w_ada, *b_ada, *norm_w, *w_in, *qln, *w_uq, *kvln, *w_ukv, *qhn, *khn, *w_out;
  float* out;
  float* ada; unsigned* counters; float* cosT; float* sinT;
  bf16_t *WinT, *WuqT, *WukvT, *WoutT, *H, *Qsb, *Ksb, *Vsb, *Gate, *CQ, *CKV; float* KR; bf16_t *Qm, *Km, *Vm, *Mixed;
};

DI unsigned pk_bf16(float lo, float hi) { f32x2 v = {lo, hi}; bf2_t b = __builtin_convertvector(v, bf2_t); return __builtin_bit_cast(unsigned, b); }
DI bf16_t to_bf16(float x) { return (bf16_t)(pk_bf16(x, 0.f) & 0xffffu); }
DI float bf_lo(unsigned u) { return __uint_as_float(u << 16); }
DI float bf_hi(unsigned u) { return __uint_as_float(u & 0xffff0000u); }
DI int crow(int i, int h) { return (i & 3) + 8 * (i >> 2) + 4 * h; }
DI u32x4 widen_pair(u32x2 a, u32x2 b) {
  const auto rx = __builtin_amdgcn_permlane32_swap(a.x, b.x, false, false);
  const auto ry = __builtin_amdgcn_permlane32_swap(a.y, b.y, false, false);
  const u32x4 w = {rx[0], ry[0], rx[1], ry[1]};
  return w;
}
DI float fast_exp2(float x) { return __builtin_amdgcn_exp2f(x); }
DI float fast_log2(float x) { return __builtin_amdgcn_logf(x); }
DI float silu_f(float v) { return v * __builtin_amdgcn_rcpf(1.f + fast_exp2(-v * LOG2E)); }


#define XB_TMO      128
#define XB_XCNT(j)  (256  + 64 * (j))
#define XB_XSUB(j)  (1280 + 64 * (j))
#define XB_XGEN(j)  (2304 + 64 * (j))
#define XB_TOP      3328
#define XB_TOPGEN   3392
#define XCD_BAR_WORDS 3456
#define XB_WQ(v)    (3520 + 64 * (v))
#define XB_LSUB(j)  (4096 + 64 * (j))
#define XB_LGEN(j)  (5120 + 64 * (j))
#define XB_TOTAL_WORDS 6144
#define XB_SPIN_CAP (1u << 22)
#define LAS __attribute__((address_space(3)))
DI unsigned xb_ld(unsigned* p) { return __hip_atomic_load(p, __ATOMIC_RELAXED, __HIP_MEMORY_SCOPE_AGENT); }
DI unsigned xb_add(unsigned* p, unsigned v) { return __hip_atomic_fetch_add(p, v, __ATOMIC_RELAXED, __HIP_MEMORY_SCOPE_AGENT); }
DI unsigned xb_xcc_id() { return (unsigned)__builtin_amdgcn_s_getreg((3 << 11) | 20) & 0xFu; }
#define XB_SPIN(cond, bar) do { unsigned _sp = 0; while (cond) { __builtin_amdgcn_s_sleep(1); \
    if ((++_sp & 255u) == 0u) { if (xb_ld(&(bar)[XB_TMO])) break; if (_sp > XB_SPIN_CAP) { atomicAdd(&(bar)[XB_TMO], 1u); break; } } } } while (0)
struct XcdBarrier { unsigned* bar; unsigned x; volatile LAS unsigned* st; };
DI XcdBarrier xcd_barrier_post(unsigned* bar, volatile LAS unsigned* st) {
  XcdBarrier b; b.bar = bar; b.x = xb_xcc_id(); b.st = st;
  if (threadIdx.x == 0) st[2] = xb_add(&bar[XB_XCNT(b.x)], 1u);
  return b;
}
DI void xcd_barrier_complete(unsigned* bar, unsigned x, unsigned& nloc, unsigned& nx, unsigned& xi) {
  const unsigned G = gridDim.x * gridDim.y * gridDim.z;
  unsigned sum, cnt, mine, below, sp = 0u;
  for (;;) {
    sum = 0u; cnt = 0u; mine = 0u; below = 0u;
#pragma unroll
    for (unsigned j = 0; j < 16; ++j) { const unsigned c = xb_ld(&bar[XB_XCNT(j)]); sum += c; cnt += (c > 0u) ? 1u : 0u; mine = (j == x) ? c : mine; below += (j < x && c > 0u) ? 1u : 0u; }
    if (sum == G) break;
    __builtin_amdgcn_s_sleep(1);
    if ((++sp & 255u) == 0u) { if (xb_ld(&bar[XB_TMO])) break; if (sp > XB_SPIN_CAP) { atomicAdd(&bar[XB_TMO], 1u); break; } }
  }
  nloc = mine > 0u ? mine : 1u; nx = cnt > 0u ? cnt : 1u; xi = below;
}
DI void xcd_census(const XcdBarrier& b) {
  if (threadIdx.x == 0) { unsigned nloc, nx, xi; xcd_barrier_complete(b.bar, b.x, nloc, nx, xi); b.st[0] = nloc; b.st[1] = nx; b.st[3] = xi; }
}
DI void xcd_barrier(const XcdBarrier& b) {
  asm volatile("s_waitcnt vmcnt(0)" ::: "memory");
  __syncthreads();
  if (threadIdx.x == 0) {
    unsigned* bar = b.bar;
    __builtin_amdgcn_s_waitcnt(0);
    const unsigned nloc = b.st[0], nx = b.st[1];
    const unsigned old = xb_add(&bar[XB_XSUB(b.x)], 1u);
    const unsigned gen = old / nloc;
    if (old + 1u == (gen + 1u) * nloc) {
      __builtin_amdgcn_fence(__ATOMIC_RELEASE, "agent");
      asm volatile("s_waitcnt vmcnt(0)" ::: "memory");
      const unsigned og = xb_add(&bar[XB_TOP], 1u);
      const unsigned tg = og / nx;
      if (og + 1u == (tg + 1u) * nx) xb_add(&bar[XB_TOPGEN], 1u);
      else XB_SPIN(xb_ld(&bar[XB_TOPGEN]) == tg, bar);
      __builtin_amdgcn_fence(__ATOMIC_ACQUIRE, "agent");
      xb_add(&bar[XB_XGEN(b.x)], 1u);
      asm volatile("s_waitcnt vmcnt(0)" ::: "memory");
    } else {
      XB_SPIN(xb_ld(&bar[XB_XGEN(b.x)]) == gen, bar);
      __builtin_amdgcn_fence(__ATOMIC_ACQUIRE, "agent");
      asm volatile("s_waitcnt vmcnt(0)" ::: "memory");
    }
  }
  __syncthreads();
}

DI void xcd_local_barrier(const XcdBarrier& b) {
  asm volatile("s_waitcnt vmcnt(0)" ::: "memory");
  __syncthreads();
  if (threadIdx.x == 0) {
    unsigned* bar = b.bar;
    __builtin_amdgcn_s_waitcnt(0);
    const unsigned nloc = b.st[0];
    const unsigned old = xb_add(&bar[XB_LSUB(b.x)], 1u);
    const unsigned gen = old / nloc;
    if (old + 1u == (gen + 1u) * nloc) xb_add(&bar[XB_LGEN(b.x)], 1u);
    else XB_SPIN(xb_ld(&bar[XB_LGEN(b.x)]) == gen, bar);
    __builtin_amdgcn_fence(__ATOMIC_ACQUIRE, "agent");
    asm volatile("s_waitcnt vmcnt(0)" ::: "memory");
  }
  __syncthreads();
}

struct Sched { int xi, nx, rank, nloc; };

DI void transpose_tile(const float* __restrict__ W, bf16_t* __restrict__ out, int K, int N, int k0, int n0, const float* __restrict__ scale, float* tile) {
  const int tid = threadIdx.x;
  float tv[16];
#pragma unroll
  for (int i = 0; i < 16; ++i) {
    const int kk = i * 4 + (tid >> 6), nn = tid & 63, n = n0 + nn;
    tv[i] = (n < N) ? W[(size_t)(k0 + kk) * N + n] : 0.f;
  }
#pragma unroll
  for (int i = 0; i < 16; ++i) {
    const int kk = i * 4 + (tid >> 6), nn = tid & 63;
    float v = tv[i];
    if (scale) v *= scale[k0 + kk];
    tile[kk * 65 + nn] = v;
  }
  __syncthreads();
#pragma unroll
  for (int i = 0; i < 2; ++i) {
    const int nn = i * 32 + (tid >> 3), kk8 = (tid & 7) * 8;
    u32x4 w;
#pragma unroll
    for (int e = 0; e < 4; ++e) w[e] = pk_bf16(tile[(kk8 + 2 * e) * 65 + nn], tile[(kk8 + 2 * e + 1) * 65 + nn]);
    *(u32x4*)(out + (size_t)(n0 + nn) * K + k0 + kk8) = w;
  }
  __syncthreads();
}

DI void ada_item(const Params& p, float* red, int item) {
  const int tid = threadIdx.x, col = tid & 15, ks = tid >> 4, n = item * 16 + col;
  float a0 = 0.f, a1 = 0.f;
#pragma unroll
  for (int kq = 0; kq < 2; ++kq) {
    float wv[32];
#pragma unroll
    for (int j = 0; j < 32; ++j) wv[j] = p.w_ada[(size_t)(ks * 64 + kq * 32 + j) * 3072 + n];
#pragma unroll
    for (int j = 0; j < 32; ++j) {
      const int k = ks * 64 + kq * 32 + j;
      const float c0 = p.c[k], c1 = p.c[1024 + k];
      a0 += (c0 / (1.f + __expf(-c0))) * wv[j];
      a1 += (c1 / (1.f + __expf(-c1))) * wv[j];
    }
  }
  red[(ks * 16 + col) * 2 + 0] = a0;
  red[(ks * 16 + col) * 2 + 1] = a1;
  __syncthreads();
  if (tid < 32) {
    const int cc = tid & 15, b = tid >> 4;
    float s = 0.f;
    for (int q = 0; q < 16; ++q) s += red[(q * 16 + cc) * 2 + b];
    p.ada[b * 3072 + item * 16 + cc] = s + p.b_ada[item * 16 + cc];
  }
  __syncthreads();
}

DI void rope_item(const Params& p, int item) {
  const int idx = item * 256 + threadIdx.x, token = idx >> 4, j = idx & 15;
  const float ang = (float)p.pos[token] * kInvFreq[j];
  const double a = (double)ang;
  const double n = rint(a * 0.6366197723675814);
  double r = fma(-n, 1.5707963267948966, a);
  r = fma(-n, 6.123233995736766e-17, r);
  const int q = ((int)n) & 3;
  const double r2 = r * r;
  const double sn = r * (1.0 + r2 * (-1.0 / 6 + r2 * (1.0 / 120 + r2 * (-1.0 / 5040 + r2 * (1.0 / 362880 + r2 * (-1.0 / 39916800))))));
  const double cs = 1.0 + r2 * (-0.5 + r2 * (1.0 / 24 + r2 * (-1.0 / 720 + r2 * (1.0 / 40320 + r2 * (-1.0 / 3628800 + r2 * (1.0 / 479001600))))));
  double co, si;
  if (q == 0) { co = cs; si = sn; } else if (q == 1) { co = -sn; si = cs; } else if (q == 2) { co = -cs; si = -sn; } else { co = sn; si = -cs; }
  p.cosT[idx] = (float)co;
  p.sinT[idx] = (float)si;
}

DI void phase0(const Params& p, char* smem, int bid, int nb) {
  constexpr int N_ADA = 192, N_TIN = 16 * 52, N_TUQ = 6 * 12, N_TUKV = 4 * 16, N_TOUT = 16 * 16, N_ROPE = 1024;
  constexpr int TOTAL = N_ADA + N_TIN + N_TUQ + N_TUKV + N_TOUT + N_ROPE;
  float* tile = (float*)smem;
  for (int it = bid; it < TOTAL; it += nb) {
    int i = it;
    if (i < N_ADA) { ada_item(p, tile, i); continue; }
    i -= N_ADA;
    if (i < N_TIN) { transpose_tile(p.w_in, p.WinT, 1024, INC, (i / 52) * 64, (i % 52) * 64, nullptr, tile); continue; }
    i -= N_TIN;
    if (i < N_TUQ) { transpose_tile(p.w_uq, p.WuqT, 384, 768, (i / 12) * 64, (i % 12) * 64, p.qln, tile); continue; }
    i -= N_TUQ;
    if (i < N_TUKV) { transpose_tile(p.w_ukv, p.WukvT, 256, 1024, (i / 16) * 64, (i % 16) * 64, p.kvln, tile); continue; }
    i -= N_TUKV;
    if (i < N_TOUT) { transpose_tile(p.w_out, p.WoutT, 1024, 1024, (i / 16) * 64, (i % 16) * 64, nullptr, tile); continue; }
    i -= N_TOUT;
    rope_item(p, i);
  }
}

DI void phase1(const Params& p, const Sched sc) {
  const int tid = threadIdx.x, lane = tid & 63, wave = tid >> 6;
  for (int v = sc.xi; v < 8; v += sc.nx)
  for (int l = sc.rank; l < 128; l += sc.nloc) {
    const int rowa = v * 2048 + l * 16 + wave * 4, b = rowa >> 13;
    f32x4 v4[4][4];
#pragma unroll
    for (int q = 0; q < 4; ++q) {
      const f32x4* xr = (const f32x4*)(p.x + (size_t)(rowa + q) * DM);
#pragma unroll
      for (int i = 0; i < 2; ++i) { v4[q][2 * i] = xr[2 * lane + 128 * i]; v4[q][2 * i + 1] = xr[2 * lane + 128 * i + 1]; }
    }
    const float* ad = p.ada + b * 3072;
    f32x4 nw[4], sh[4];
#pragma unroll
    for (int j = 0; j < 4; ++j) {
      const int k = (2 * lane + 128 * (j >> 1) + (j & 1)) * 4;
      nw[j] = *(const f32x4*)(p.norm_w + k); sh[j] = *(const f32x4*)(ad + k);
      const f32x4 sc4 = *(const f32x4*)(ad + 1024 + k);
#pragma unroll
      for (int e = 0; e < 4; ++e) nw[j][e] *= 1.f + sc4[e];
    }
#pragma unroll
    for (int q = 0; q < 4; ++q) {
      float ss = 0.f;
#pragma unroll
      for (int j = 0; j < 4; ++j) ss += v4[q][j][0] * v4[q][j][0] + v4[q][j][1] * v4[q][j][1] + v4[q][j][2] * v4[q][j][2] + v4[q][j][3] * v4[q][j][3];
#pragma unroll
      for (int o = 1; o < 64; o <<= 1) ss += __shfl_xor(ss, o);
      const float rstd = rsqrtf(ss * (1.f / DM) + 1e-6f);
#pragma unroll
      for (int i = 0; i < 2; ++i) {
        u32x4 w;
#pragma unroll
        for (int jj = 0; jj < 2; ++jj) {
          const int j = 2 * i + jj;
          float o[4];
#pragma unroll
          for (int e = 0; e < 4; ++e) o[e] = (v4[q][j][e] * rstd) * nw[j][e] + sh[j][e];
          w[2 * jj] = pk_bf16(o[0], o[1]); w[2 * jj + 1] = pk_bf16(o[2], o[3]);
        }
        *(u32x4*)(p.H + (size_t)(rowa + q) * DM + (2 * lane + 128 * i) * 4) = w;
      }
    }
  }
}

template <int RM, int CN, int WR, int WC, bool SUMSQ, int BK = 64, bool FDB = false>
DI void gemm_tile_core(const bf16_t* __restrict__ Rg, int ldr, const bf16_t* __restrict__ Cg, int ldc, int K, char* smem,
                       f32x16 (&acc)[RM / WR / 32][CN / WC / 32], float* sumsq,
                       u32x4 (&rr)[2][RM * BK / 2048], u32x4 (&cr)[2][CN * BK / 2048], long dR, long dC, bool cold) {
  constexpr int MI = RM / WR / 32, NI = CN / WC / 32, STR = BK + 8, CPR = BK / 8, RPP = 256 / CPR, KS = BK / 16;
  constexpr int RCH = RM / RPP, CCH = CN / RPP, BUFE = (RM + CN) * STR;
  bf16_t* lds = (bf16_t*)smem;
  const int tid = threadIdx.x, lane = tid & 63, wave = tid >> 6, r = lane & 31, h = lane >> 5;
  const int wr = wave / WC, wc = wave % WC;
  const int srow = tid / CPR, skc = (tid % CPR) * 8;
  float ss[CCH];
#pragma unroll
  for (int i = 0; i < CCH; ++i) ss[i] = 0.f;
#pragma unroll
  for (int mi = 0; mi < MI; ++mi)
#pragma unroll
    for (int ni = 0; ni < NI; ++ni)
#pragma unroll
      for (int i = 0; i < 16; ++i) acc[mi][ni][i] = 0.f;
  const bf16_t* rp = Rg + (size_t)srow * ldr + skc;
  const bf16_t* cp = Cg + (size_t)srow * ldc + skc;
  const int nk = K / BK;
#define GT_LOAD(SET, KT) { const int k0_ = (KT) * BK; \
    _Pragma("unroll") for (int i = 0; i < RCH; ++i) rr[SET][i] = *(const u32x4*)(rp + (size_t)(RPP * i) * ldr + k0_); \
    _Pragma("unroll") for (int i = 0; i < CCH; ++i) cr[SET][i] = *(const u32x4*)(cp + (size_t)(RPP * i) * ldc + k0_); \
    __builtin_amdgcn_sched_barrier(0); }
#define GT_WRITE(SET, BUF, COUNT) { \
    _Pragma("unroll") for (int i = 0; i < RCH; ++i) *(u32x4*)((BUF) + (srow + RPP * i) * STR + skc) = rr[SET][i]; \
    _Pragma("unroll") for (int i = 0; i < CCH; ++i) *(u32x4*)((BUF) + (RM + srow + RPP * i) * STR + skc) = cr[SET][i]; \
    if (SUMSQ && (COUNT)) { _Pragma("unroll") for (int i = 0; i < CCH; ++i) { _Pragma("unroll") for (int e = 0; e < 4; ++e) { const float a_ = bf_lo(cr[SET][i][e]), b_ = bf_hi(cr[SET][i][e]); ss[i] += a_ * a_ + b_ * b_; } } } }
  if (cold) {
    GT_LOAD(0, 0)
    GT_LOAD(1, 1)
    GT_WRITE(0, lds, true)
    GT_LOAD(0, (2 < nk) ? 2 : nk - 1)
    __syncthreads();
  }
  for (int kt2 = 0; kt2 < nk; kt2 += 2) {
#pragma unroll
    for (int st = 0; st < 2; ++st) {
      const int kt = kt2 + st;
      const bf16_t* cur = lds + st * BUFE;
      bf16_t* oth = lds + (st ^ 1) * BUFE;
      const long k0r = (kt + 3 < nk) ? (long)(kt + 3) * BK : dR + (long)(kt + 3 - nk) * BK;
      const long k0c = (kt + 3 < nk) ? (long)(kt + 3) * BK : dC + (long)(kt + 3 - nk) * BK;
      const bool cnt = kt + 1 < nk;
      const bf16_t* abase = cur + (wr * (RM / WR) + r) * STR + h * 8;
      const bf16_t* bbase = cur + (RM + wc * (CN / WC) + r) * STR + h * 8;
      bf16x8 af[2][MI], bfr[2][NI];
      if (FDB) {
#pragma unroll
        for (int mi = 0; mi < MI; ++mi) af[0][mi] = *(const bf16x8*)(abase + mi * 32 * STR);
#pragma unroll
        for (int ni = 0; ni < NI; ++ni) bfr[0][ni] = *(const bf16x8*)(bbase + ni * 32 * STR);
      }
#pragma unroll
      for (int ks = 0; ks < KS; ++ks) {
        if (!FDB) {
#pragma unroll
          for (int mi = 0; mi < MI; ++mi) af[ks & 1][mi] = *(const bf16x8*)(abase + mi * 32 * STR + ks * 16);
#pragma unroll
          for (int ni = 0; ni < NI; ++ni) bfr[ks & 1][ni] = *(const bf16x8*)(bbase + ni * 32 * STR + ks * 16);
        }
#pragma unroll
        for (int c = ks; c < RCH; c += KS) *(u32x4*)(oth + (srow + RPP * c) * STR + skc) = rr[st ^ 1][c];
#pragma unroll
        for (int c = ks; c < CCH; c += KS) {
          *(u32x4*)(oth + (RM + srow + RPP * c) * STR + skc) = cr[st ^ 1][c];
          if (SUMSQ && cnt) {
#pragma unroll
            for (int e = 0; e < 4; ++e) { const float a_ = bf_lo(cr[st ^ 1][c][e]), b_ = bf_hi(cr[st ^ 1][c][e]); ss[c] += a_ * a_ + b_ * b_; }
          }
        }
#pragma unroll
        for (int c = ks; c < RCH; c += KS) rr[st ^ 1][c] = *(const u32x4*)(rp + (size_t)(RPP * c) * ldr + k0r);
#pragma unroll
        for (int c = ks; c < CCH; c += KS) cr[st ^ 1][c] = *(const u32x4*)(cp + (size_t)(RPP * c) * ldc + k0c);
        __builtin_amdgcn_sched_barrier(0);
        if (FDB && ks + 1 < KS) {
#pragma unroll
          for (int mi = 0; mi < MI; ++mi) af[(ks + 1) & 1][mi] = *(const bf16x8*)(abase + mi * 32 * STR + (ks + 1) * 16);
#pragma unroll
          for (int ni = 0; ni < NI; ++ni) bfr[(ks + 1) & 1][ni] = *(const bf16x8*)(bbase + ni * 32 * STR + (ks + 1) * 16);
        }
#pragma unroll
        for (int mi = 0; mi < MI; ++mi)
#pragma unroll
          for (int ni = 0; ni < NI; ++ni) acc[mi][ni] = MFMA32(af[ks & 1][mi], bfr[ks & 1][ni], acc[mi][ni]);
      }
      __syncthreads();
    }
  }
#undef GT_LOAD
#undef GT_WRITE
  if (SUMSQ) {
#pragma unroll
    for (int i = 0; i < CCH; ++i) {
      float s = ss[i];
      s += __shfl_xor(s, 1); s += __shfl_xor(s, 2);
      if (CPR == 8) s += __shfl_xor(s, 4);
      if ((tid % CPR) == 0) sumsq[srow + RPP * i] = s;
    }
  }
  __syncthreads();
}

template <int RM, int CN, int WR, int WC, bool SUMSQ, bool FDB = false>
DI void gemm_tile(const bf16_t* __restrict__ Rg, int ldr, const bf16_t* __restrict__ Cg, int ldc, int K, char* smem,
                  f32x16 (&acc)[RM / WR / 32][CN / WC / 32], float* sumsq) {
  u32x4 rr[2][RM / 32], cr[2][CN / 32];
  gemm_tile_core<RM, CN, WR, WC, SUMSQ, 64, FDB>(Rg, ldr, Cg, ldc, K, smem, acc, sumsq, rr, cr, 0, 0, true);
}

template <int NI>
DI void p2_store_group(const Params& p, const f32x16 (&a)[NI], int colg, int tok0, int b, int h) {
  if (colg >= INC) return;
  bf16_t* base; int stride, mode = 0, use_s = 0; float scale = 1.f;
  if (colg < 1536) {
    const int which = colg >> 9, hh = (colg & 511) >> 6, d0 = colg & 63;
    base = (which == 0 ? p.Qsb : (which == 1 ? p.Ksb : p.Vsb)) + (size_t)(b * 8 + hh) * S_ * 64 + d0; stride = 64; use_s = 1;
    if (which == 0) scale = 0.125f * LOG2E;
  } else if (colg < 2048) { base = p.Gate + (colg - 1536); stride = 1024; mode = 1; }
  else if (colg < 2432) { base = p.CQ + (colg - 2048); stride = 384; }
  else if (colg < 2688) { base = p.CKV + (colg - 2432); stride = 256; }
  else if (colg < 2720) { base = nullptr; stride = 32; mode = 2; }
  else { base = p.Gate + 512 + (colg - 2720); stride = 1024; mode = 1; }
#pragma unroll
  for (int ni = 0; ni < NI; ++ni) {
    const int token = tok0 + ni * 32;
    const int idx = use_s ? (token & (S_ - 1)) : token;
    if (mode == 2) {
      float* d = p.KR + (size_t)token * 32 + 4 * h;
#pragma unroll
      for (int g = 0; g < 4; ++g) { f32x4 v = {a[ni][4 * g], a[ni][4 * g + 1], a[ni][4 * g + 2], a[ni][4 * g + 3]}; *(f32x4*)(d + 8 * g) = v; }
    } else {
      bf16_t* d = base + (size_t)idx * stride + 8 * h;
#pragma unroll
      for (int q = 0; q < 2; ++q) {
        u32x2 w[2];
#pragma unroll
        for (int gg = 0; gg < 2; ++gg) {
          const int g = 2 * q + gg;
          float v0 = a[ni][4 * g] * scale, v1 = a[ni][4 * g + 1] * scale, v2 = a[ni][4 * g + 2] * scale, v3 = a[ni][4 * g + 3] * scale;
          if (mode == 1) { v0 = silu_f(v0); v1 = silu_f(v1); v2 = silu_f(v2); v3 = silu_f(v3); }
          w[gg].x = pk_bf16(v0, v1); w[gg].y = pk_bf16(v2, v3);
        }
        *(u32x4*)(d + 16 * q) = widen_pair(w[0], w[1]);
        __builtin_amdgcn_sched_barrier(0);
      }
    }
  }
}

DI void phase2(const Params& p, char* smem, const Sched sc) {
  const int tid = threadIdx.x, lane = tid & 63, wave = tid >> 6, r = lane & 31, h = lane >> 5, wr = wave >> 1, wc = wave & 1;
  constexpr int NFULL = 384, NLIST = 16 * 26;
  u32x4 rr[2][4], cr[2][4];
  for (int v = sc.xi; v < 8; v += sc.nx) {
    bool cold = true;
    for (int l = sc.rank; l < NFULL; l += sc.nloc) {
      const int g8 = l / (8 * 26), rem = l % (8 * 26), nt = rem >> 3, mt = 16 * v + 8 * g8 + (rem & 7), m0 = mt * 128, n0 = nt * 128;
      const int l2 = l + sc.nloc;
      long dR = 0, dC = 0;
      if (l2 < NFULL) {
        const int g8n = l2 / (8 * 26), remn = l2 % (8 * 26), ntn = remn >> 3, mtn = 16 * v + 8 * g8n + (remn & 7);
        dR = (long)(ntn * 128 - n0) * DM; dC = (long)(mtn * 128 - m0) * DM;
      }
      f32x16 acc[2][2];
      gemm_tile_core<128, 128, 2, 2, false, 64, true>(p.WinT + (size_t)n0 * DM, DM, p.H + (size_t)m0 * DM, DM, DM, smem, acc, nullptr, rr, cr, dR, dC, cold);
      cold = false;
#pragma unroll
      for (int mi = 0; mi < 2; ++mi) p2_store_group<2>(p, acc[mi], n0 + wr * 64 + mi * 32, m0 + wc * 64 + r, m0 >> 13, h);
    }
    for (int hl = sc.rank; hl < 2 * (NLIST - NFULL); hl += sc.nloc) {
      const int l = NFULL + (hl >> 1);
      const int g8 = l / (8 * 26), rem = l % (8 * 26), nt = rem >> 3, mt = 16 * v + 8 * g8 + (rem & 7), m0 = mt * 128, n0 = nt * 128 + 64 * (hl & 1);
      if (n0 >= INC) continue;
      f32x16 acc[2][1];
      gemm_tile<64, 128, 1, 4, false>(p.WinT + (size_t)n0 * DM, DM, p.H + (size_t)m0 * DM, DM, DM, smem, acc, nullptr);
#pragma unroll
      for (int mi = 0; mi < 2; ++mi) p2_store_group<1>(p, acc[mi], n0 + mi * 32, m0 + wave * 32 + r, m0 >> 13, h);
    }
  }
}

DI void phase3(const Params& p, char* smem, const Sched sc) {
  const int tid = threadIdx.x, lane = tid & 63, wave = tid >> 6, r = lane & 31, h = lane >> 5;
  float* sumsq = (float*)(smem + 2 * 256 * 72 * 2);
  for (int v = sc.xi; v < 8; v += sc.nx)
  for (int l = sc.rank; l < 16 * 16; l += sc.nloc) {
    const int mt = 16 * v + (l >> 4), sub = l & 15, head = sub & 7, m0 = mt * 128;
    const int tl = wave * 32 + r, token = m0 + tl, b = token >> 13, s = token & (S_ - 1);
    if (sub < 8) {
      f32x16 acc[3][1];
      gemm_tile<96, 128, 1, 4, true>(p.WuqT + (size_t)head * 96 * 384, 384, p.CQ + (size_t)m0 * 384, 384, 384, smem, acc, sumsq);
      const float rstd = rsqrtf(sumsq[tl] * (1.f / 384) + 1e-6f);
      float ssq = 0.f;
#pragma unroll
      for (int rb = 0; rb < 3; ++rb)
#pragma unroll
        for (int i = 0; i < 16; ++i) { const float v = acc[rb][0][i] * rstd; acc[rb][0][i] = v; ssq += v * v; }
      ssq += __shfl_xor(ssq, 32);
      const float r2 = rsqrtf(ssq * (1.f / 96) + 1e-6f);
#pragma unroll
      for (int rb = 0; rb < 3; ++rb)
#pragma unroll
        for (int g = 0; g < 4; ++g) {
          const f32x4 w4 = *(const f32x4*)(p.qhn + rb * 32 + 8 * g + 4 * h);
#pragma unroll
          for (int e = 0; e < 4; ++e) acc[rb][0][4 * g + e] *= r2 * w4[e];
        }
#pragma unroll
      for (int g = 0; g < 2; ++g) {
        const f32x4 c4 = *(const f32x4*)(p.cosT + (size_t)token * 16 + 8 * g + 4 * h), s4 = *(const f32x4*)(p.sinT + (size_t)token * 16 + 8 * g + 4 * h);
#pragma unroll
        for (int e = 0; e < 4; ++e) {
          const float x1 = acc[2][0][4 * g + e], x2 = acc[2][0][4 * (g + 2) + e];
          acc[2][0][4 * g + e] = x1 * c4[e] - x2 * s4[e];
          acc[2][0][4 * (g + 2) + e] = x2 * c4[e] + x1 * s4[e];
        }
      }
      const float qs = LOG2E * 0.10206207261596577f;
      bf16_t* dst = p.Qm + ((size_t)(b * 8 + head) * S_ + s) * 96;
#pragma unroll
      for (int rb = 0; rb < 3; ++rb) {
        u32x2 w[4];
#pragma unroll
        for (int g = 0; g < 4; ++g) { w[g].x = pk_bf16(acc[rb][0][4 * g] * qs, acc[rb][0][4 * g + 1] * qs); w[g].y = pk_bf16(acc[rb][0][4 * g + 2] * qs, acc[rb][0][4 * g + 3] * qs); }
#pragma unroll
        for (int q = 0; q < 2; ++q) *(u32x4*)(dst + rb * 32 + 16 * q + 8 * h) = widen_pair(w[2 * q], w[2 * q + 1]);
      }
    } else {
      f32x16 acc[4][1];
      gemm_tile<128, 128, 1, 4, true>(p.WukvT + (size_t)head * 128 * 256, 256, p.CKV + (size_t)m0 * 256, 256, 256, smem, acc, sumsq);
      const float rstd = rsqrtf(sumsq[tl] * (1.f / 256) + 1e-6f);
      float kr[16];
#pragma unroll
      for (int g = 0; g < 4; ++g) {
        const f32x4 k4 = *(const f32x4*)(p.KR + (size_t)token * 32 + 8 * g + 4 * h);
#pragma unroll
        for (int e = 0; e < 4; ++e) kr[4 * g + e] = k4[e];
      }
      float ssq = 0.f;
#pragma unroll
      for (int rb = 0; rb < 2; ++rb)
#pragma unroll
        for (int i = 0; i < 16; ++i) { const float v = acc[rb][0][i] * rstd; acc[rb][0][i] = v; ssq += v * v; }
#pragma unroll
      for (int i = 0; i < 16; ++i) ssq += kr[i] * kr[i];
      ssq += __shfl_xor(ssq, 32);
      const float r2 = rsqrtf(ssq * (1.f / 96) + 1e-6f);
#pragma unroll
      for (int rb = 0; rb < 2; ++rb)
#pragma unroll
        for (int g = 0; g < 4; ++g) {
          const f32x4 w4 = *(const f32x4*)(p.khn + rb * 32 + 8 * g + 4 * h);
#pragma unroll
          for (int e = 0; e < 4; ++e) acc[rb][0][4 * g + e] *= r2 * w4[e];
        }
#pragma unroll
      for (int g = 0; g < 4; ++g) {
        const f32x4 w4 = *(const f32x4*)(p.khn + 64 + 8 * g + 4 * h);
#pragma unroll
        for (int e = 0; e < 4; ++e) kr[4 * g + e] *= r2 * w4[e];
      }
#pragma unroll
      for (int g = 0; g < 2; ++g) {
        const f32x4 c4 = *(const f32x4*)(p.cosT + (size_t)token * 16 + 8 * g + 4 * h), s4 = *(const f32x4*)(p.sinT + (size_t)token * 16 + 8 * g + 4 * h);
#pragma unroll
        for (int e = 0; e < 4; ++e) {
          const float x1 = kr[4 * g + e], x2 = kr[4 * (g + 2) + e];
          kr[4 * g + e] = x1 * c4[e] - x2 * s4[e];
          kr[4 * (g + 2) + e] = x2 * c4[e] + x1 * s4[e];
        }
      }
      bf16_t* dk = p.Km + ((size_t)(b * 8 + head) * S_ + s) * 96;
      bf16_t* dv = p.Vm + ((size_t)(b * 8 + head) * S_ + s) * 64;
#pragma unroll
      for (int rb = 0; rb < 2; ++rb) {
        u32x2 w[4], u[4];
#pragma unroll
        for (int g = 0; g < 4; ++g) {
          w[g].x = pk_bf16(acc[rb][0][4 * g], acc[rb][0][4 * g + 1]); w[g].y = pk_bf16(acc[rb][0][4 * g + 2], acc[rb][0][4 * g + 3]);
          u[g].x = pk_bf16(acc[rb + 2][0][4 * g] * rstd, acc[rb + 2][0][4 * g + 1] * rstd); u[g].y = pk_bf16(acc[rb + 2][0][4 * g + 2] * rstd, acc[rb + 2][0][4 * g + 3] * rstd);
        }
#pragma unroll
        for (int q = 0; q < 2; ++q) {
          *(u32x4*)(dk + rb * 32 + 16 * q + 8 * h) = widen_pair(w[2 * q], w[2 * q + 1]);
          *(u32x4*)(dv + rb * 32 + 16 * q + 8 * h) = widen_pair(u[2 * q], u[2 * q + 1]);
        }
      }
      {
        u32x2 w[4];
#pragma unroll
        for (int g = 0; g < 4; ++g) { w[g].x = pk_bf16(kr[4 * g], kr[4 * g + 1]); w[g].y = pk_bf16(kr[4 * g + 2], kr[4 * g + 3]); }
#pragma unroll
        for (int q = 0; q < 2; ++q) *(u32x4*)(dk + 64 + 16 * q + 8 * h) = widen_pair(w[2 * q], w[2 * q + 1]);
      }
    }
  }
}

template <int DQK, bool SB, bool SMAX>
DI void attn_item(const Params& p, char* smem, int bh, int qb, float Mb) {
  constexpr int KSTR = DQK + 8, VSTR = 72, NKS = DQK / 16, KCH = DQK / 8, KPT = 64 * KCH / 256, KBUF = 64 * KSTR, VBUF = 64 * VSTR;
  bf16_t* Ks = (bf16_t*)smem;
  bf16_t* Vs = Ks + 2 * KBUF;
  int* flags = (int*)(Vs + 2 * VBUF);
  const bf16_t* Qg = SB ? p.Qsb : p.Qm;
  const bf16_t* Kg = (SB ? p.Ksb : p.Km) + (size_t)bh * S_ * DQK;
  const bf16_t* Vg = (SB ? p.Vsb : p.Vm) + (size_t)bh * S_ * 64;
  const int tid = threadIdx.x, lane = tid & 63, wave = tid >> 6, r = lane & 31, h = lane >> 5;
  const int q0 = qb * 128, qw0 = q0 + wave * 32, query = qw0 + r;
  bf16x8 qf[NKS];
  {
    const bf16_t* qp = Qg + ((size_t)bh * S_ + query) * DQK + h * 8;
#pragma unroll
    for (int ks = 0; ks < NKS; ++ks) qf[ks] = *(const bf16x8*)(qp + ks * 16);
  }
  bf16x8 tri[2], ones;
#pragma unroll
  for (int s = 0; s < 2; ++s)
#pragma unroll
    for (int j = 0; j < 8; ++j) tri[s][j] = ((16 * s + 8 * (j >> 2) + 4 * h + (j & 3)) >= r) ? (short)0x3F80 : (short)0;
#pragma unroll
  for (int j = 0; j < 8; ++j) ones[j] = (short)0x3F80;

  const int nt = 2 * (qb + 1);
  f32x16 O[2];
#pragma unroll
  for (int db = 0; db < 2; ++db)
#pragma unroll
    for (int i = 0; i < 16; ++i) O[db][i] = 0.f;
  float m = -__builtin_huge_valf(), lsum = 0.f, carry = 0.f;
  f32x16 negM;
#pragma unroll
  for (int i = 0; i < 16; ++i) negM[i] = -Mb;

  u32x4 kreg[1][KPT], vreg[1][2];
#define AT_KB(IT) (SB ? 64 * (nt - 1 - (IT)) : 64 * (IT))
#define AT_LOAD(SET, IT) { const int kl_ = AT_KB(IT); \
    _Pragma("unroll") for (int i = 0; i < KPT; ++i) kreg[SET][i] = *(const u32x4*)(Kg + (size_t)kl_ * DQK + (tid + 256 * i) * 8); \
    _Pragma("unroll") for (int i = 0; i < 2; ++i) vreg[SET][i] = *(const u32x4*)(Vg + (size_t)kl_ * 64 + (tid + 256 * i) * 8); \
    __builtin_amdgcn_sched_barrier(0); }
#define AT_WRITE(SET, BUFI) { \
    _Pragma("unroll") for (int i = 0; i < KPT; ++i) { const int c = tid + 256 * i, row = c / KCH, kcol = c % KCH; *(u32x4*)(Ks + (BUFI) * KBUF + row * KSTR + kcol * 8) = kreg[SET][i]; } \
    _Pragma("unroll") for (int i = 0; i < 2; ++i) { const int c = tid + 256 * i; *(u32x4*)(Vs + (BUFI) * VBUF + (c >> 3) * VSTR + (c & 7) * 8) = vreg[SET][i]; } }
  const int blk = (lane >> 4) & 1, tq = (lane & 15) >> 2, tp = lane & 3;
  const int voff = (4 * h + tq) * VSTR + 16 * blk + 4 * tp;

  AT_LOAD(0, 0)
  AT_WRITE(0, 0)
  AT_LOAD(0, 1)
  __syncthreads();
  bool stop = false;
  for (int it2 = 0; it2 < nt && !stop; it2 += 2) {
#pragma unroll
   for (int st2 = 0; st2 < 2; ++st2) {
    const int it = it2 + st2;
    const int kb0 = AT_KB(it);
    const bf16_t* kc = Ks + st2 * KBUF;
    const bf16_t* vc = Vs + st2 * VBUF;
    const bool active = kb0 < qw0 + 32;
    f32x16 st[2];
    if (active) {
#pragma unroll
      for (int kb = 0; kb < 2; ++kb)
#pragma unroll
        for (int i = 0; i < 16; ++i) st[kb][i] = SMAX ? negM[i] : 0.f;
#pragma unroll
      for (int ks = 0; ks < NKS; ++ks)
#pragma unroll
        for (int kb = 0; kb < 2; ++kb) {
          const bf16x8 a = *(const bf16x8*)(kc + (kb * 32 + r) * KSTR + ks * 16 + h * 8);
          st[kb] = MFMA32(a, qf[ks], st[kb]);
        }
    }
    __builtin_amdgcn_sched_barrier(0);
    AT_WRITE(0, st2 ^ 1)
    AT_LOAD(0, (it + 2 < nt) ? it + 2 : nt - 1)
    if (active) {
      const bool diag = (kb0 + 64 > qw0);
      bf16x8 pk[4];
      if (!SB) {
        if (diag) {
#pragma unroll
          for (int kb = 0; kb < 2; ++kb)
#pragma unroll
            for (int i = 0; i < 16; ++i) { const int key = kb0 + kb * 32 + crow(i, h); if (key > query) st[kb][i] = -__builtin_huge_valf(); }
        }
        if (SMAX) {
          float ps = 0.f;
#pragma unroll
          for (int kb = 0; kb < 2; ++kb)
#pragma unroll
            for (int i = 0; i < 16; ++i) { const float pv = fast_exp2(st[kb][i]); st[kb][i] = pv; ps += pv; }
          lsum += ps;
        } else {
        float mx = st[0][0];
#pragma unroll
        for (int kb = 0; kb < 2; ++kb)
#pragma unroll
          for (int i = 0; i < 16; ++i) mx = fmaxf(mx, st[kb][i]);
        mx = fmaxf(mx, __shfl_xor(mx, 32));
        const float mnew = fmaxf(m, mx);
        const float alpha = fast_exp2(m - mnew);
        m = mnew;
        float ps = 0.f;
#pragma unroll
        for (int kb = 0; kb < 2; ++kb)
#pragma unroll
          for (int i = 0; i < 16; ++i) { const float pv = fast_exp2(st[kb][i] - mnew); st[kb][i] = pv; ps += pv; }
        lsum = lsum * alpha + ps;
#pragma unroll
        for (int db = 0; db < 2; ++db)
#pragma unroll
          for (int i = 0; i < 16; ++i) O[db][i] *= alpha;
        }
      } else {
        f32x16 ca[2];
        bf16x8 hi[4], lo[4];
        float tsum = 0.f;
#pragma unroll
        for (int kb = 0; kb < 2; ++kb)
#pragma unroll
          for (int i2 = 0; i2 < 8; ++i2) {
            float lk[2];
#pragma unroll
            for (int e = 0; e < 2; ++e) {
              const int i = 2 * i2 + e;
              const float z = fminf(st[kb][i], 100.f);
              const int key = kb0 + kb * 32 + crow(i, h);
              const bool valid = !diag || (key < query);
              float l = -fast_log2(1.f + fast_exp2(z));
              l = valid ? l : 0.f;
              lk[e] = l;
              tsum += l;
              ca[kb][i] = z + carry;
            }
            const unsigned hp = pk_bf16(lk[0], lk[1]);
            const unsigned lp = pk_bf16(lk[0] - bf_lo(hp), lk[1] - bf_hi(hp));
            const int kk = kb * 2 + (i2 >> 2), w = i2 & 3;
            hi[kk][2 * w] = (short)(hp & 0xffffu); hi[kk][2 * w + 1] = (short)(hp >> 16);
            lo[kk][2 * w] = (short)(lp & 0xffffu); lo[kk][2 * w + 1] = (short)(lp >> 16);
          }
        tsum += __shfl_xor(tsum, 32);
#pragma unroll
        for (int s = 0; s < 2; ++s) {
          ca[0] = MFMA32(tri[s], hi[s], ca[0]);
          ca[0] = MFMA32(tri[s], lo[s], ca[0]);
          ca[0] = MFMA32(ones, hi[2 + s], ca[0]);
          ca[0] = MFMA32(ones, lo[2 + s], ca[0]);
          ca[1] = MFMA32(tri[s], hi[2 + s], ca[1]);
          ca[1] = MFMA32(tri[s], lo[2 + s], ca[1]);
        }
#pragma unroll
        for (int kb = 0; kb < 2; ++kb)
#pragma unroll
          for (int i = 0; i < 16; ++i) {
            const int key = kb0 + kb * 32 + crow(i, h);
            const bool valid = !diag || (key < query);
            st[kb][i] = valid ? fast_exp2(ca[kb][i]) : 0.f;
          }
        carry += tsum;
      }
#pragma unroll
      for (int kb = 0; kb < 2; ++kb)
#pragma unroll
        for (int s = 0; s < 2; ++s) {
          u32x4 w;
#pragma unroll
          for (int e = 0; e < 4; ++e) w[e] = pk_bf16(st[kb][8 * s + 2 * e], st[kb][8 * s + 2 * e + 1]);
          pk[kb * 2 + s] = __builtin_bit_cast(bf16x8, w);
        }
#pragma unroll
      for (int kk = 0; kk < 4; ++kk)
#pragma unroll
        for (int db = 0; db < 2; ++db) {
          const s16x4 v0 = __builtin_amdgcn_ds_read_tr16_b64_v4i16((lds_s16x4*)(vc + voff + (16 * kk) * VSTR + 32 * db));
          const s16x4 v1 = __builtin_amdgcn_ds_read_tr16_b64_v4i16((lds_s16x4*)(vc + voff + (16 * kk + 8) * VSTR + 32 * db));
          const bf16x8 vf = __builtin_shufflevector(v0, v1, 0, 1, 2, 3, 4, 5, 6, 7);
          O[db] = MFMA32(vf, pk[kk], O[db]);
        }
    }
    if (SB) {
      const bool alive = __builtin_amdgcn_ballot_w64(carry > -64.f) != 0ull;
      if (lane == 0) flags[st2 * 4 + wave] = alive ? 1 : 0;
    }
    __syncthreads();
    if (SB) {
      const int any = flags[st2 * 4 + 0] | flags[st2 * 4 + 1] | flags[st2 * 4 + 2] | flags[st2 * 4 + 3];
      if (!any) { stop = true; break; }
    }
   }
  }
#undef AT_KB
#undef AT_LOAD
#undef AT_WRITE
  float inv = 1.f;
  if (!SB) { const float lt = lsum + __shfl_xor(lsum, 32); inv = 1.f / lt; }
  const size_t token = (size_t)(bh >> 3) * S_ + query;
  const int colbase = (SB ? 0 : 512) + (bh & 7) * 64;
#pragma unroll
  for (int db = 0; db < 2; ++db) {
    u32x2 w[4];
#pragma unroll
    for (int g = 0; g < 4; ++g) {
      const int col = colbase + db * 32 + 8 * g + 4 * h;
      const u32x2 gt = *(const u32x2*)(p.Gate + token * 1024 + col);
      w[g].x = pk_bf16(O[db][4 * g] * inv * bf_lo(gt.x), O[db][4 * g + 1] * inv * bf_hi(gt.x));
      w[g].y = pk_bf16(O[db][4 * g + 2] * inv * bf_lo(gt.y), O[db][4 * g + 3] * inv * bf_hi(gt.y));
    }
#pragma unroll
    for (int q = 0; q < 2; ++q) *(u32x4*)(p.Mixed + token * 1024 + colbase + db * 32 + 16 * q + 8 * h) = widen_pair(w[2 * q], w[2 * q + 1]);
  }
  __syncthreads();
}

DI void phase4(const Params& p, char* smem, const Sched sc) {
  int* s_item = (int*)(smem + LDS_BYTES - 16);
  float gq = 0.f, gk = 0.f;
  for (int i = 0; i < 96; ++i) { gq = fmaxf(gq, fabsf(p.qhn[i])); gk = fmaxf(gk, fabsf(p.khn[i])); }
  const float Mb = LOG2E * 9.797958971132712f * gq * gk * 1.02f;
  const bool smax = Mb < 56.f;
  for (int v = sc.xi; v < 8; v += sc.nx)
  for (;;) {
    if (threadIdx.x == 0) *s_item = (int)atomicAdd(&p.counters[XB_WQ(v)], 1u);
    __syncthreads();
    const int item = *s_item;
    __syncthreads();
    if (item >= 256) break;
    if (item < 128) {
      const int bh = 2 * v + (item & 1), qb = 63 - (item >> 1);
      if (smax) attn_item<96, false, true>(p, smem, bh, qb, Mb);
      else attn_item<96, false, false>(p, smem, bh, qb, 0.f);
    } else { const int j = item - 128; attn_item<64, true, false>(p, smem, 2 * v + (j & 1), 63 - (j >> 1), 0.f); }
  }
}

DI void phase5(const Params& p, char* smem, const Sched sc) {
  const int tid = threadIdx.x, lane = tid & 63, wave = tid >> 6, r = lane & 31, h = lane >> 5, wr = wave >> 1, wc = wave & 1;
  constexpr int CST = 132;
  float* ct = (float*)smem;
  for (int v = sc.xi; v < 8; v += sc.nx)
  for (int l = sc.rank; l < 16 * 8; l += sc.nloc) {
    const int g8 = l >> 6, rem = l & 63, nt = rem >> 3, mt = 16 * v + 8 * g8 + (rem & 7), m0 = mt * 128, n0 = nt * 128;
    f32x16 acc[2][2];
    gemm_tile<128, 128, 2, 2, false, true>(p.WoutT + (size_t)n0 * DM, DM, p.Mixed + (size_t)m0 * DM, DM, DM, smem, acc, nullptr);
    const int b = m0 >> 13;
#pragma unroll
    for (int mi = 0; mi < 2; ++mi)
#pragma unroll
      for (int ni = 0; ni < 2; ++ni)
#pragma unroll
        for (int g = 0; g < 4; ++g) {
          const f32x4 vv = {acc[mi][ni][4 * g], acc[mi][ni][4 * g + 1], acc[mi][ni][4 * g + 2], acc[mi][ni][4 * g + 3]};
          *(f32x4*)(ct + (wc * 64 + ni * 32 + r) * CST + wr * 64 + mi * 32 + 8 * g + 4 * h) = vv;
        }
    __syncthreads();
    const int c4 = (tid & 31) * 4, row0 = tid >> 5;
    const f32x4 gt = *(const f32x4*)(p.ada + b * 3072 + 2048 + n0 + c4);
#pragma unroll
    for (int half = 0; half < 2; ++half) {
      f32x4 xv[8];
#pragma unroll
      for (int j = 0; j < 8; ++j) xv[j] = *(const f32x4*)(p.x + (size_t)(m0 + row0 + 8 * (half * 8 + j)) * DM + n0 + c4);
#pragma unroll
      for (int j = 0; j < 8; ++j) {
        const int row = row0 + 8 * (half * 8 + j);
        const f32x4 cv = *(const f32x4*)(ct + row * CST + c4);
        f32x4 o;
#pragma unroll
        for (int e = 0; e < 4; ++e) o[e] = xv[j][e] + gt[e] * cv[e];
        *(f32x4*)(p.out + (size_t)(m0 + row) * DM + n0 + c4) = o;
      }
    }
    __syncthreads();
  }
}

#if !ONE_LAUNCH
template <int PH>
__global__ void __launch_bounds__(256, 2) k_phase(Params p) {
  __shared__ __attribute__((aligned(16))) char smem[LDS_BYTES];
  const int bid = blockIdx.x, nb = gridDim.x;
  Sched sc; sc.xi = bid & 7; sc.nx = 8; sc.rank = bid >> 3; sc.nloc = nb >> 3;
  if (PH == 0) phase0(p, smem, bid, nb);
  if (PH == 1) phase1(p, sc);
  if (PH == 2) phase2(p, smem, sc);
  if (PH == 3) phase3(p, smem, sc);
  if (PH == 4) phase4(p, smem, sc);
  if (PH == 5) phase5(p, smem, sc);
}

#else
__global__ void __launch_bounds__(256, 2) k_mega(Params p) {
  __shared__ __attribute__((aligned(16))) char smem[LDS_BYTES];
  __shared__ uint4 xb_words;
  if (p.out == nullptr) cg::this_grid().sync();
  const int bid = blockIdx.x, nb = gridDim.x;
  if (threadIdx.x == 0) xb_words = make_uint4(0u, 0u, 0u, 0u);
  __syncthreads();
  const XcdBarrier xb = xcd_barrier_post(p.counters, (volatile LAS unsigned*)&xb_words);
  phase0(p, smem, bid, nb);
  xcd_census(xb);
  xcd_barrier(xb);
  Sched sc; sc.nloc = (int)xb_words.x; sc.nx = (int)xb_words.y; sc.rank = (int)xb_words.z; sc.xi = (int)xb_words.w;
  if (__builtin_amdgcn_readfirstlane(sc.rank) * 2 >= __builtin_amdgcn_readfirstlane(sc.nloc)) __builtin_amdgcn_s_setprio(1);
  phase1(p, sc);
  xcd_local_barrier(xb);
  phase2(p, smem, sc);
  xcd_local_barrier(xb);
  phase3(p, smem, sc);
  xcd_barrier(xb);
  phase4(p, smem, sc);
  xcd_barrier(xb);
  phase5(p, smem, sc);
}

#endif

extern "C" void kernel_launch(void* const* d_in, const int* in_sizes, int n_in, void* d_out, int out_size, void* d_ws, size_t ws_size, hipStream_t stream) {
  Params p{};
  p.x = (const float*)d_in[0]; p.c = (const float*)d_in[1]; p.pos = (const int*)d_in[2];
  p.w_ada = (const float*)d_in[3]; p.b_ada = (const float*)d_in[4]; p.norm_w = (const float*)d_in[5]; p.w_in = (const float*)d_in[6];
  p.qln = (const float*)d_in[7]; p.w_uq = (const float*)d_in[8]; p.kvln = (const float*)d_in[9]; p.w_ukv = (const float*)d_in[10];
  p.qhn = (const float*)d_in[11]; p.khn = (const float*)d_in[12]; p.w_out = (const float*)d_in[13];
  p.out = (float*)d_out;
  char* w = (char*)d_ws;
  size_t off = 0;
  auto take = [&](size_t bytes) { char* q = w + off; off += (bytes + 255) & ~(size_t)255; return q; };
  p.ada = (float*)take(2 * 3072 * 4);
  p.counters = (unsigned*)take(XB_TOTAL_WORDS * 4);
  p.cosT = (float*)take((size_t)NTOK * 16 * 4);
  p.sinT = (float*)take((size_t)NTOK * 16 * 4);
  p.WinT = (bf16_t*)take((size_t)INPAD * 1024 * 2);
  p.WuqT = (bf16_t*)take((size_t)768 * 384 * 2);
  p.WukvT = (bf16_t*)take((size_t)1024 * 256 * 2);
  p.WoutT = (bf16_t*)take((size_t)1024 * 1024 * 2);
  p.H = (bf16_t*)take((size_t)NTOK * 1024 * 2);
  p.Qsb = (bf16_t*)take((size_t)NTOK * 512 * 2);
  p.Ksb = (bf16_t*)take((size_t)NTOK * 512 * 2);
  p.Vsb = (bf16_t*)take((size_t)NTOK * 512 * 2);
  p.Gate = (bf16_t*)take((size_t)NTOK * 1024 * 2);
  p.CQ = (bf16_t*)take((size_t)NTOK * 384 * 2);
  p.CKV = (bf16_t*)take((size_t)NTOK * 256 * 2);
  p.KR = (float*)take((size_t)NTOK * 32 * 4);
  p.Qm = (bf16_t*)take((size_t)NTOK * 768 * 2);
  p.Km = (bf16_t*)take((size_t)NTOK * 768 * 2);
  p.Vm = (bf16_t*)take((size_t)NTOK * 512 * 2);
  p.Mixed = p.H;
  hipMemsetAsync(p.counters, 0, XB_TOTAL_WORDS * 4, stream);
#if ONE_LAUNCH
  static int grid_blocks = 0;
  if (!grid_blocks) {
    int dev = 0, cus = 0, per_cu = 0;
    hipGetDevice(&dev);
    hipDeviceGetAttribute(&cus, hipDeviceAttributeMultiprocessorCount, dev);
    hipOccupancyMaxActiveBlocksPerMultiprocessor(&per_cu, k_mega, 256, 0);
    if (per_cu > 2) per_cu = 2;
    if (per_cu < 1) per_cu = 1;
    grid_blocks = cus * per_cu;
  }
  void* args[] = {&p};
  hipError_t e = hipLaunchCooperativeKernel((void*)k_mega, dim3(grid_blocks), dim3(256), args, 0, stream);
  if (e != hipSuccess) fprintf(stderr, "cooperative launch failed: %s (grid %d)\n", hipGetErrorString(e), grid_blocks);
#else
  const int G = 512;
#ifndef DUP_PHASE
#define DUP_PHASE -1
#endif
  k_phase<0><<<G, 256, 0, stream>>>(p);
  if (DUP_PHASE == 0) k_phase<0><<<G, 256, 0, stream>>>(p);
  k_phase<1><<<G, 256, 0, stream>>>(p);
  if (DUP_PHASE == 1) k_phase<1><<<G, 256, 0, stream>>>(p);
  k_phase<2><<<G, 256, 0, stream>>>(p);
  if (DUP_PHASE == 2) k_phase<2><<<G, 256, 0, stream>>>(p);
  k_phase<3><<<G, 256, 0, stream>>>(p);
  if (DUP_PHASE == 3) k_phase<3><<<G, 256, 0, stream>>>(p);
  k_phase<4><<<G, 256, 0, stream>>>(p);
  if (DUP_PHASE == 4) { hipMemsetAsync(p.counters, 0, XB_TOTAL_WORDS * 4, stream); k_phase<4><<<G, 256, 0, stream>>>(p); }
  k_phase<5><<<G, 256, 0, stream>>>(p);
  if (DUP_PHASE == 5) k_phase<5><<<G, 256, 0, stream>>>(p);
#endif
}
```

```cpp
#include <hip/hip_runtime.h>
#include <hip/hip_cooperative_groups.h>
#include <cstdio>
#include <cstdint>
namespace cg = cooperative_groups;

#ifndef ONE_LAUNCH
#define ONE_LAUNCH 1
#endif

typedef unsigned short bf16_t;
typedef short bf16x8 __attribute__((ext_vector_type(8)));
typedef short s16x4 __attribute__((ext_vector_type(4)));
typedef float f32x16 __attribute__((ext_vector_type(16)));
typedef float f32x4 __attribute__((ext_vector_type(4)));
typedef float f32x2 __attribute__((ext_vector_type(2)));
typedef __bf16 bf2_t __attribute__((ext_vector_type(2)));
typedef unsigned u32x4 __attribute__((ext_vector_type(4)));
typedef unsigned u32x2 __attribute__((ext_vector_type(2)));
typedef __attribute__((address_space(3))) s16x4 lds_s16x4;

#define DI __device__ __forceinline__
#define MFMA32(a, b, c) __builtin_amdgcn_mfma_f32_32x32x16_bf16((a), (b), (c), 0, 0, 0)

constexpr int S_ = 8192, NTOK = 16384, DM = 1024, INC = 3232, INPAD = 3328;
constexpr float LOG2E = 1.4426950408889634f;
constexpr int LDS_BYTES = 2 * 256 * 72 * 2 + 1024;

__device__ const float kInvFreq[16] = {1.0f, 0.5623413324356079f, 0.3162277638912201f, 0.17782793939113617f, 0.10000000149011612f, 0.05623413249850273f, 0.03162277489900589f, 0.017782794311642647f, 0.009999999776482582f, 0.005623413249850273f, 0.003162277629598975f, 0.0017782794311642647f, 0.0010000000474974513f, 0.000562341301701963f, 0.0003162277571391314f, 0.00017782794020604342f};

struct Params {
  const float *x, *c; const int* pos; const float *w_ada, *b_ada, *norm_w, *w_in, *qln, *w_uq, *kvln, *w_ukv, *qhn, *khn, *w_out;
  float* out;
  float* ada; unsigned* counters; float* cosT; float* sinT;
  bf16_t *WinT, *WuqT, *WukvT, *WoutT, *H, *Qsb, *Ksb, *Vsb, *Gate, *CQ, *CKV; float* KR; bf16_t *Qm, *Km, *Vm, *Mixed;
};

DI unsigned pk_bf16(float lo, float hi) { f32x2 v = {lo, hi}; bf2_t b = __builtin_convertvector(v, bf2_t); return __builtin_bit_cast(unsigned, b); }
DI bf16_t to_bf16(float x) { return (bf16_t)(pk_bf16(x, 0.f) & 0xffffu); }
DI float bf_lo(unsigned u) { return __uint_as_float(u << 16); }
DI float bf_hi(unsigned u) { return __uint_as_float(u & 0xffff0000u); }
DI int crow(int i, int h) { return (i & 3) + 8 * (i >> 2) + 4 * h; }
DI u32x4 widen_pair(u32x2 a, u32x2 b) {
  const auto rx = __builtin_amdgcn_permlane32_swap(a.x, b.x, false, false);
  const auto ry = __builtin_amdgcn_permlane32_swap(a.y, b.y, false, false);
  const u32x4 w = {rx[0], ry[0], rx[1], ry[1]};
  return w;
}
DI float fast_exp2(float x) { return __builtin_amdgcn_exp2f(x); }
DI float fast_log2(float x) { return __builtin_amdgcn_logf(x); }
DI float silu_f(float v) { return v * __builtin_amdgcn_rcpf(1.f + fast_exp2(-v * LOG2E)); }


#define XB_TMO      128
#define XB_XCNT(j)  (256  + 64 * (j))
#define XB_XSUB(j)  (1280 + 64 * (j))
#define XB_XGEN(j)  (2304 + 64 * (j))
#define XB_TOP      3328
#define XB_TOPGEN   3392
#define XCD_BAR_WORDS 3456
#define XB_WQ(v)    (3520 + 64 * (v))
#define XB_LSUB(j)  (4096 + 64 * (j))
#define XB_LGEN(j)  (5120 + 64 * (j))
#define XB_TOTAL_WORDS 6144
#define XB_SPIN_CAP (1u << 22)
#define LAS __attribute__((address_space(3)))
DI unsigned xb_ld(unsigned* p) { return __hip_atomic_load(p, __ATOMIC_RELAXED, __HIP_MEMORY_SCOPE_AGENT); }
DI unsigned xb_add(unsigned* p, unsigned v) { return __hip_atomic_fetch_add(p, v, __ATOMIC_RELAXED, __HIP_MEMORY_SCOPE_AGENT); }
DI unsigned xb_xcc_id() { return (unsigned)__builtin_amdgcn_s_getreg((3 << 11) | 20) & 0xFu; }
#define XB_SPIN(cond, bar) do { unsigned _sp = 0; while (cond) { __builtin_amdgcn_s_sleep(1); \
    if ((++_sp & 255u) == 0u) { if (xb_ld(&(bar)[XB_TMO])) break; if (_sp > XB_SPIN_CAP) { atomicAdd(&(bar)[XB_TMO], 1u); break; } } } } while (0)
struct XcdBarrier { unsigned* bar; unsigned x; volatile LAS unsigned* st; };
DI XcdBarrier xcd_barrier_post(unsigned* bar, volatile LAS unsigned* st) {
  XcdBarrier b; b.bar = bar; b.x = xb_xcc_id(); b.st = st;
  if (threadIdx.x == 0) st[2] = xb_add(&bar[XB_XCNT(b.x)], 1u);
  return b;
}
DI void xcd_barrier_complete(unsigned* bar, unsigned x, unsigned& nloc, unsigned& nx, unsigned& xi) {
  const unsigned G = gridDim.x * gridDim.y * gridDim.z;
  unsigned sum, cnt, mine, below, sp = 0u;
  for (;;) {
    sum = 0u; cnt = 0u; mine = 0u; below = 0u;
#pragma unroll
    for (unsigned j = 0; j < 16; ++j) { const unsigned c = xb_ld(&bar[XB_XCNT(j)]); sum += c; cnt += (c > 0u) ? 1u : 0u; mine = (j == x) ? c : mine; below += (j < x && c > 0u) ? 1u : 0u; }
    if (sum == G) break;
    __builtin_amdgcn_s_sleep(1);
    if ((++sp & 255u) == 0u) { if (xb_ld(&bar[XB_TMO])) break; if (sp > XB_SPIN_CAP) { atomicAdd(&bar[XB_TMO], 1u); break; } }
  }
  nloc = mine > 0u ? mine : 1u; nx = cnt > 0u ? cnt : 1u; xi = below;
}
DI void xcd_census(const XcdBarrier& b) {
  if (threadIdx.x == 0) { unsigned nloc, nx, xi; xcd_barrier_complete(b.bar, b.x, nloc, nx, xi); b.st[0] = nloc; b.st[1] = nx; b.st[3] = xi; }
}
DI void xcd_barrier(const XcdBarrier& b) {
  asm volatile("s_waitcnt vmcnt(0)" ::: "memory");
  __syncthreads();
  if (threadIdx.x == 0) {
    unsigned* bar = b.bar;
    __builtin_amdgcn_s_waitcnt(0);
    const unsigned nloc = b.st[0], nx = b.st[1];
    const unsigned old = xb_add(&bar[XB_XSUB(b.x)], 1u);
    const unsigned gen = old / nloc;
    if (old + 1u == (gen + 1u) * nloc) {
      __builtin_amdgcn_fence(__ATOMIC_RELEASE, "agent");
      asm volatile("s_waitcnt vmcnt(0)" ::: "memory");
      const unsigned og = xb_add(&bar[XB_TOP], 1u);
      const unsigned tg = og / nx;
      if (og + 1u == (tg + 1u) * nx) xb_add(&bar[XB_TOPGEN], 1u);
      else XB_SPIN(xb_ld(&bar[XB_TOPGEN]) == tg, bar);
      __builtin_amdgcn_fence(__ATOMIC_ACQUIRE, "agent");
      xb_add(&bar[XB_XGEN(b.x)], 1u);
      asm volatile("s_waitcnt vmcnt(0)" ::: "memory");
    } else {
      XB_SPIN(xb_ld(&bar[XB_XGEN(b.x)]) == gen, bar);
      __builtin_amdgcn_fence(__ATOMIC_ACQUIRE, "agent");
      asm volatile("s_waitcnt vmcnt(0)" ::: "memory");
    }
  }
  __syncthreads();
}

DI void xcd_local_barrier(const XcdBarrier& b) {
  asm volatile("s_waitcnt vmcnt(0)" ::: "memory");
  __syncthreads();
  if (threadIdx.x == 0) {
    unsigned* bar = b.bar;
    __builtin_amdgcn_s_waitcnt(0);
    const unsigned nloc = b.st[0];
    const unsigned old = xb_add(&bar[XB_LSUB(b.x)], 1u);
    const unsigned gen = old / nloc;
    if (old + 1u == (gen + 1u) * nloc) xb_add(&bar[XB_LGEN(b.x)], 1u);
    else XB_SPIN(xb_ld(&bar[XB_LGEN(b.x)]) == gen, bar);
    __builtin_amdgcn_fence(__ATOMIC_ACQUIRE, "agent");
    asm volatile("s_waitcnt vmcnt(0)" ::: "memory");
  }
  __syncthreads();
}

struct Sched { int xi, nx, rank, nloc; };

DI void transpose_tile(const float* __restrict__ W, bf16_t* __restrict__ out, int K, int N, int k0, int n0, const float* __restrict__ scale, float* tile) {
  const int tid = threadIdx.x;
  float tv[16];
#pragma unroll
  for (int i = 0; i < 16; ++i) {
    const int kk = i * 4 + (tid >> 6), nn = tid & 63, n = n0 + nn;
    tv[i] = (n < N) ? W[(size_t)(k0 + kk) * N + n] : 0.f;
  }
#pragma unroll
  for (int i = 0; i < 16; ++i) {
    const int kk = i * 4 + (tid >> 6), nn = tid & 63;
    float v = tv[i];
    if (scale) v *= scale[k0 + kk];
    tile[kk * 65 + nn] = v;
  }
  __syncthreads();
#pragma unroll
  for (int i = 0; i < 2; ++i) {
    const int nn = i * 32 + (tid >> 3), kk8 = (tid & 7) * 8;
    u32x4 w;
#pragma unroll
    for (int e = 0; e < 4; ++e) w[e] = pk_bf16(tile[(kk8 + 2 * e) * 65 + nn], tile[(kk8 + 2 * e + 1) * 65 + nn]);
    *(u32x4*)(out + (size_t)(n0 + nn) * K + k0 + kk8) = w;
  }
  __syncthreads();
}

DI void ada_item(const Params& p, float* red, int item) {
  const int tid = threadIdx.x, col = tid & 15, ks = tid >> 4, n = item * 16 + col;
  float a0 = 0.f, a1 = 0.f;
#pragma unroll
  for (int kq = 0; kq < 2; ++kq) {
    float wv[32];
#pragma unroll
    for (int j = 0; j < 32; ++j) wv[j] = p.w_ada[(size_t)(ks * 64 + kq * 32 + j) * 3072 + n];
#pragma unroll
    for (int j = 0; j < 32; ++j) {
      const int k = ks * 64 + kq * 32 + j;
      const float c0 = p.c[k], c1 = p.c[1024 + k];
      a0 += (c0 / (1.f + __expf(-c0))) * wv[j];
      a1 += (c1 / (1.f + __expf(-c1))) * wv[j];
    }
  }
  red[(ks * 16 + col) * 2 + 0] = a0;
  red[(ks * 16 + col) * 2 + 1] = a1;
  __syncthreads();
  if (tid < 32) {
    const int cc = tid & 15, b = tid >> 4;
    float s = 0.f;
    for (int q = 0; q < 16; ++q) s += red[(q * 16 + cc) * 2 + b];
    p.ada[b * 3072 + item * 16 + cc] = s + p.b_ada[item * 16 + cc];
  }
  __syncthreads();
}

DI void rope_item(const Params& p, int item) {
  const int idx = item * 256 + threadIdx.x, token = idx >> 4, j = idx & 15;
  const float ang = (float)p.pos[token] * kInvFreq[j];
  const double a = (double)ang;
  const double n = rint(a * 0.6366197723675814);
  double r = fma(-n, 1.5707963267948966, a);
  r = fma(-n, 6.123233995736766e-17, r);
  const int q = ((int)n) & 3;
  const double r2 = r * r;
  const double sn = r * (1.0 + r2 * (-1.0 / 6 + r2 * (1.0 / 120 + r2 * (-1.0 / 5040 + r2 * (1.0 / 362880 + r2 * (-1.0 / 39916800))))));
  const double cs = 1.0 + r2 * (-0.5 + r2 * (1.0 / 24 + r2 * (-1.0 / 720 + r2 * (1.0 / 40320 + r2 * (-1.0 / 3628800 + r2 * (1.0 / 479001600))))));
  double co, si;
  if (q == 0) { co = cs; si = sn; } else if (q == 1) { co = -sn; si = cs; } else if (q == 2) { co = -cs; si = -sn; } else { co = sn; si = -cs; }
  p.cosT[idx] = (float)co;
  p.sinT[idx] = (float)si;
}

DI void phase0(const Params& p, char* smem, int bid, int nb) {
  constexpr int N_ADA = 192, N_TIN = 16 * 52, N_TUQ = 6 * 12, N_TUKV = 4 * 16, N_TOUT = 16 * 16, N_ROPE = 1024;
  constexpr int TOTAL = N_ADA + N_TIN + N_TUQ + N_TUKV + N_TOUT + N_ROPE;
  float* tile = (float*)smem;
  for (int it = bid; it < TOTAL; it += nb) {
    int i = it;
    if (i < N_ADA) { ada_item(p, tile, i); continue; }
    i -= N_ADA;
    if (i < N_TIN) { transpose_tile(p.w_in, p.WinT, 1024, INC, (i / 52) * 64, (i % 52) * 64, nullptr, tile); continue; }
    i -= N_TIN;
    if (i < N_TUQ) { transpose_tile(p.w_uq, p.WuqT, 384, 768, (i / 12) * 64, (i % 12) * 64, p.qln, tile); continue; }
    i -= N_TUQ;
    if (i < N_TUKV) { transpose_tile(p.w_ukv, p.WukvT, 256, 1024, (i / 16) * 64, (i % 16) * 64, p.kvln, tile); continue; }
    i -= N_TUKV;
    if (i < N_TOUT) { transpose_tile(p.w_out, p.WoutT, 1024, 1024, (i / 16) * 64, (i % 16) * 64, nullptr, tile); continue; }
    i -= N_TOUT;
    rope_item(p, i);
  }
}

DI void phase1(const Params& p, const Sched sc) {
  const int tid = threadIdx.x, lane = tid & 63, wave = tid >> 6;
  for (int v = sc.xi; v < 8; v += sc.nx)
  for (int l = sc.rank; l < 128; l += sc.nloc) {
    const int rowa = v * 2048 + l * 16 + wave * 4, b = rowa >> 13;
    f32x4 v4[4][4];
#pragma unroll
    for (int q = 0; q < 4; ++q) {
      const f32x4* xr = (const f32x4*)(p.x + (size_t)(rowa + q) * DM);
#pragma unroll
      for (int i = 0; i < 2; ++i) { v4[q][2 * i] = xr[2 * lane + 128 * i]; v4[q][2 * i + 1] = xr[2 * lane + 128 * i + 1]; }
    }
    const float* ad = p.ada + b * 3072;
    f32x4 nw[4], sh[4];
#pragma unroll
    for (int j = 0; j < 4; ++j) {
      const int k = (2 * lane + 128 * (j >> 1) + (j & 1)) * 4;
      nw[j] = *(const f32x4*)(p.norm_w + k); sh[j] = *(const f32x4*)(ad + k);
      const f32x4 sc4 = *(const f32x4*)(ad + 1024 + k);
#pragma unroll
      for (int e = 0; e < 4; ++e) nw[j][e] *= 1.f + sc4[e];
    }
#pragma unroll
    for (int q = 0; q < 4; ++q) {
      float ss = 0.f;
#pragma unroll
      for (int j = 0; j < 4; ++j) ss += v4[q][j][0] * v4[q][j][0] + v4[q][j][1] * v4[q][j][1] + v4[q][j][2] * v4[q][j][2] + v4[q][j][3] * v4[q][j][3];
#pragma unroll
      for (int o = 1; o < 64; o <<= 1) ss += __shfl_xor(ss, o);
      const float rstd = rsqrtf(ss * (1.f / DM) + 1e-6f);
#pragma unroll
      for (int i = 0; i < 2; ++i) {
        u32x4 w;
#pragma unroll
        for (int jj = 0; jj < 2; ++jj) {
          const int j = 2 * i + jj;
          float o[4];
#pragma unroll
          for (int e = 0; e < 4; ++e) o[e] = (v4[q][j][e] * rstd) * nw[j][e] + sh[j][e];
          w[2 * jj] = pk_bf16(o[0], o[1]); w[2 * jj + 1] = pk_bf16(o[2], o[3]);
        }
        *(u32x4*)(p.H + (size_t)(rowa + q) * DM + (2 * lane + 128 * i) * 4) = w;
      }
    }
  }
}

template <int RM, int CN, int WR, int WC, bool SUMSQ, int BK = 64, bool FDB = false>
DI void gemm_tile_core(const bf16_t* __restrict__ Rg, int ldr, const bf16_t* __restrict__ Cg, int ldc, int K, char* smem,
                       f32x16 (&acc)[RM / WR / 32][CN / WC / 32], float* sumsq,
                       u32x4 (&rr)[2][RM * BK / 2048], u32x4 (&cr)[2][CN * BK / 2048], long dR, long dC, bool cold) {
  constexpr int MI = RM / WR / 32, NI = CN / WC / 32, STR = BK + 8, CPR = BK / 8, RPP = 256 / CPR, KS = BK / 16;
  constexpr int RCH = RM / RPP, CCH = CN / RPP, BUFE = (RM + CN) * STR;
  bf16_t* lds = (bf16_t*)smem;
  const int tid = threadIdx.x, lane = tid & 63, wave = tid >> 6, r = lane & 31, h = lane >> 5;
  const int wr = wave / WC, wc = wave % WC;
  const int srow = tid / CPR, skc = (tid % CPR) * 8;
  float ss[CCH];
#pragma unroll
  for (int i = 0; i < CCH; ++i) ss[i] = 0.f;
#pragma unroll
  for (int mi = 0; mi < MI; ++mi)
#pragma unroll
    for (int ni = 0; ni < NI; ++ni)
#pragma unroll
      for (int i = 0; i < 16; ++i) acc[mi][ni][i] = 0.f;
  const bf16_t* rp = Rg + (size_t)srow * ldr + skc;
  const bf16_t* cp = Cg + (size_t)srow * ldc + skc;
  const int nk = K / BK;
#define GT_LOAD(SET, KT) { const int k0_ = (KT) * BK; \
    _Pragma("unroll") for (int i = 0; i < RCH; ++i) rr[SET][i] = *(const u32x4*)(rp + (size_t)(RPP * i) * ldr + k0_); \
    _Pragma("unroll") for (int i = 0; i < CCH; ++i) cr[SET][i] = *(const u32x4*)(cp + (size_t)(RPP * i) * ldc + k0_); \
    __builtin_amdgcn_sched_barrier(0); }
#define GT_WRITE(SET, BUF, COUNT) { \
    _Pragma("unroll") for (int i = 0; i < RCH; ++i) *(u32x4*)((BUF) + (srow + RPP * i) * STR + skc) = rr[SET][i]; \
    _Pragma("unroll") for (int i = 0; i < CCH; ++i) *(u32x4*)((BUF) + (RM + srow + RPP * i) * STR + skc) = cr[SET][i]; \
    if (SUMSQ && (COUNT)) { _Pragma("unroll") for (int i = 0; i < CCH; ++i) { _Pragma("unroll") for (int e = 0; e < 4; ++e) { const float a_ = bf_lo(cr[SET][i][e]), b_ = bf_hi(cr[SET][i][e]); ss[i] += a_ * a_ + b_ * b_; } } } }
  if (cold) {
    GT_LOAD(0, 0)
    GT_LOAD(1, 1)
    GT_WRITE(0, lds, true)
    GT_LOAD(0, (2 < nk) ? 2 : nk - 1)
    __syncthreads();
  }
  for (int kt2 = 0; kt2 < nk; kt2 += 2) {
#pragma unroll
    for (int st = 0; st < 2; ++st) {
      const int kt = kt2 + st;
      const bf16_t* cur = lds + st * BUFE;
      bf16_t* oth = lds + (st ^ 1) * BUFE;
      const long k0r = (kt + 3 < nk) ? (long)(kt + 3) * BK : dR + (long)(kt + 3 - nk) * BK;
      const long k0c = (kt + 3 < nk) ? (long)(kt + 3) * BK : dC + (long)(kt + 3 - nk) * BK;
      const bool cnt = kt + 1 < nk;
      const bf16_t* abase = cur + (wr * (RM / WR) + r) * STR + h * 8;
      const bf16_t* bbase = cur + (RM + wc * (CN / WC) + r) * STR + h * 8;
      bf16x8 af[2][MI], bfr[2][NI];
      if (FDB) {
#pragma unroll
        for (int mi = 0; mi < MI; ++mi) af[0][mi] = *(const bf16x8*)(abase + mi * 32 * STR);
#pragma unroll
        for (int ni = 0; ni < NI; ++ni) bfr[0][ni] = *(const bf16x8*)(bbase + ni * 32 * STR);
      }
#pragma unroll
      for (int ks = 0; ks < KS; ++ks) {
        if (!FDB) {
#pragma unroll
          for (int mi = 0; mi < MI; ++mi) af[ks & 1][mi] = *(const bf16x8*)(abase + mi * 32 * STR + ks * 16);
#pragma unroll
          for (int ni = 0; ni < NI; ++ni) bfr[ks & 1][ni] = *(const bf16x8*)(bbase + ni * 32 * STR + ks * 16);
        }
#pragma unroll
        for (int c = ks; c < RCH; c += KS) *(u32x4*)(oth + (srow + RPP * c) * STR + skc) = rr[st ^ 1][c];
#pragma unroll
        for (int c = ks; c < CCH; c += KS) {
          *(u32x4*)(oth + (RM + srow + RPP * c) * STR + skc) = cr[st ^ 1][c];
          if (SUMSQ && cnt) {
#pragma unroll
            for (int e = 0; e < 4; ++e) { const float a_ = bf_lo(cr[st ^ 1][c][e]), b_ = bf_hi(cr[st ^ 1][c][e]); ss[c] += a_ * a_ + b_ * b_; }
          }
        }
#pragma unroll
        for (int c = ks; c < RCH; c += KS) rr[st ^ 1][c] = *(const u32x4*)(rp + (size_t)(RPP * c) * ldr + k0r);
#pragma unroll
        for (int c = ks; c < CCH; c += KS) cr[st ^ 1][c] = *(const u32x4*)(cp + (size_t)(RPP * c) * ldc + k0c);
        __builtin_amdgcn_sched_barrier(0);
        if (FDB && ks + 1 < KS) {
#pragma unroll
          for (int mi = 0; mi < MI; ++mi) af[(ks + 1) & 1][mi] = *(const bf16x8*)(abase + mi * 32 * STR + (ks + 1) * 16);
#pragma unroll
          for (int ni = 0; ni < NI; ++ni) bfr[(ks + 1) & 1][ni] = *(const bf16x8*)(bbase + ni * 32 * STR + (ks + 1) * 16);
        }
#pragma unroll
        for (int mi = 0; mi < MI; ++mi)
#pragma unroll
          for (int ni = 0; ni < NI; ++ni) acc[mi][ni] = MFMA32(af[ks & 1][mi], bfr[ks & 1][ni], acc[mi][ni]);
      }
      __syncthreads();
    }
  }
#undef GT_LOAD
#undef GT_WRITE
  if (SUMSQ) {
#pragma unroll
    for (int i = 0; i < CCH; ++i) {
      float s = ss[i];
      s += __shfl_xor(s, 1); s += __shfl_xor(s, 2);
      if (CPR == 8) s += __shfl_xor(s, 4);
      if ((tid % CPR) == 0) sumsq[srow + RPP * i] = s;
    }
  }
  __syncthreads();
}

template <int RM, int CN, int WR, int WC, bool SUMSQ, bool FDB = false>
DI void gemm_tile(const bf16_t* __restrict__ Rg, int ldr, const bf16_t* __restrict__ Cg, int ldc, int K, char* smem,
                  f32x16 (&acc)[RM / WR / 32][CN / WC / 32], float* sumsq) {
  u32x4 rr[2][RM / 32], cr[2][CN / 32];
  gemm_tile_core<RM, CN, WR, WC, SUMSQ, 64, FDB>(Rg, ldr, Cg, ldc, K, smem, acc, sumsq, rr, cr, 0, 0, true);
}

template <int NI>
DI void p2_store_group(const Params& p, const f32x16 (&a)[NI], int colg, int tok0, int b, int h) {
  if (colg >= INC) return;
  bf16_t* base; int stride, mode = 0, use_s = 0; float scale = 1.f;
  if (colg < 1536) {
    const int which = colg >> 9, hh = (colg & 511) >> 6, d0 = colg & 63;
    base = (which == 0 ? p.Qsb : (which == 1 ? p.Ksb : p.Vsb)) + (size_t)(b * 8 + hh) * S_ * 64 + d0; stride = 64; use_s = 1;
    if (which == 0) scale = 0.125f * LOG2E;
  } else if (colg < 2048) { base = p.Gate + (colg - 1536); stride = 1024; mode = 1; }
  else if (colg < 2432) { base = p.CQ + (colg - 2048); stride = 384; }
  else if (colg < 2688) { base = p.CKV + (colg - 2432); stride = 256; }
  else if (colg < 2720) { base = nullptr; stride = 32; mode = 2; }
  else { base = p.Gate + 512 + (colg - 2720); stride = 1024; mode = 1; }
#pragma unroll
  for (int ni = 0; ni < NI; ++ni) {
    const int token = tok0 + ni * 32;
    const int idx = use_s ? (token & (S_ - 1)) : token;
    if (mode == 2) {
      float* d = p.KR + (size_t)token * 32 + 4 * h;
#pragma unroll
      for (int g = 0; g < 4; ++g) { f32x4 v = {a[ni][4 * g], a[ni][4 * g + 1], a[ni][4 * g + 2], a[ni][4 * g + 3]}; *(f32x4*)(d + 8 * g) = v; }
    } else {
      bf16_t* d = base + (size_t)idx * stride + 8 * h;
#pragma unroll
      for (int q = 0; q < 2; ++q) {
        u32x2 w[2];
#pragma unroll
        for (int gg = 0; gg < 2; ++gg) {
          const int g = 2 * q + gg;
          float v0 = a[ni][4 * g] * scale, v1 = a[ni][4 * g + 1] * scale, v2 = a[ni][4 * g + 2] * scale, v3 = a[ni][4 * g + 3] * scale;
          if (mode == 1) { v0 = silu_f(v0); v1 = silu_f(v1); v2 = silu_f(v2); v3 = silu_f(v3); }
          w[gg].x = pk_bf16(v0, v1); w[gg].y = pk_bf16(v2, v3);
        }
        *(u32x4*)(d + 16 * q) = widen_pair(w[0], w[1]);
        __builtin_amdgcn_sched_barrier(0);
      }
    }
  }
}

DI void phase2(const Params& p, char* smem, const Sched sc) {
  const int tid = threadIdx.x, lane = tid & 63, wave = tid >> 6, r = lane & 31, h = lane >> 5, wr = wave >> 1, wc = wave & 1;
  constexpr int NFULL = 384, NLIST = 16 * 26;
  u32x4 rr[2][4], cr[2][4];
  for (int v = sc.xi; v < 8; v += sc.nx) {
    bool cold = true;
    for (int l = sc.rank; l < NFULL; l += sc.nloc) {
      const int g8 = l / (8 * 26), rem = l % (8 * 26), nt = rem >> 3, mt = 16 * v + 8 * g8 + (rem & 7), m0 = mt * 128, n0 = nt * 128;
      const int l2 = l + sc.nloc;
      long dR = 0, dC = 0;
      if (l2 < NFULL) {
        const int g8n = l2 / (8 * 26), remn = l2 % (8 * 26), ntn = remn >> 3, mtn = 16 * v + 8 * g8n + (remn & 7);
        dR = (long)(ntn * 128 - n0) * DM; dC = (long)(mtn * 128 - m0) * DM;
      }
      f32x16 acc[2][2];
      gemm_tile_core<128, 128, 2, 2, false, 64, true>(p.WinT + (size_t)n0 * DM, DM, p.H + (size_t)m0 * DM, DM, DM, smem, acc, nullptr, rr, cr, dR, dC, cold);
      cold = false;
#pragma unroll
      for (int mi = 0; mi < 2; ++mi) p2_store_group<2>(p, acc[mi], n0 + wr * 64 + mi * 32, m0 + wc * 64 + r, m0 >> 13, h);
    }
    for (int hl = sc.rank; hl < 2 * (NLIST - NFULL); hl += sc.nloc) {
      const int l = NFULL + (hl >> 1);
      const int g8 = l / (8 * 26), rem = l % (8 * 26), nt = rem >> 3, mt = 16 * v + 8 * g8 + (rem & 7), m0 = mt * 128, n0 = nt * 128 + 64 * (hl & 1);
      if (n0 >= INC) continue;
      f32x16 acc[2][1];
      gemm_tile<64, 128, 1, 4, false, true>(p.WinT + (size_t)n0 * DM, DM, p.H + (size_t)m0 * DM, DM, DM, smem, acc, nullptr);
#pragma unroll
      for (int mi = 0; mi < 2; ++mi) p2_store_group<1>(p, acc[mi], n0 + mi * 32, m0 + wave * 32 + r, m0 >> 13, h);
    }
  }
}

DI void phase3(const Params& p, char* smem, const Sched sc) {
  const int tid = threadIdx.x, lane = tid & 63, wave = tid >> 6, r = lane & 31, h = lane >> 5;
  float* sumsq = (float*)(smem + 2 * 256 * 72 * 2);
  for (int v = sc.xi; v < 8; v += sc.nx)
  for (int l = sc.rank; l < 16 * 16; l += sc.nloc) {
    const int mt = 16 * v + (l >> 4), sub = l & 15, head = sub & 7, m0 = mt * 128;
    const int tl = wave * 32 + r, token = m0 + tl, b = token >> 13, s = token & (S_ - 1);
    if (sub < 8) {
      f32x16 acc[3][1];
      gemm_tile<96, 128, 1, 4, true, true>(p.WuqT + (size_t)head * 96 * 384, 384, p.CQ + (size_t)m0 * 384, 384, 384, smem, acc, sumsq);
      const float rstd = rsqrtf(sumsq[tl] * (1.f / 384) + 1e-6f);
      float ssq = 0.f;
#pragma unroll
      for (int rb = 0; rb < 3; ++rb)
#pragma unroll
        for (int i = 0; i < 16; ++i) { const float v = acc[rb][0][i] * rstd; acc[rb][0][i] = v; ssq += v * v; }
      ssq += __shfl_xor(ssq, 32);
      const float r2 = rsqrtf(ssq * (1.f / 96) + 1e-6f);
#pragma unroll
      for (int rb = 0; rb < 3; ++rb)
#pragma unroll
        for (int g = 0; g < 4; ++g) {
          const f32x4 w4 = *(const f32x4*)(p.qhn + rb * 32 + 8 * g + 4 * h);
#pragma unroll
          for (int e = 0; e < 4; ++e) acc[rb][0][4 * g + e] *= r2 * w4[e];
        }
#pragma unroll
      for (int g = 0; g < 2; ++g) {
        const f32x4 c4 = *(const f32x4*)(p.cosT + (size_t)token * 16 + 8 * g + 4 * h), s4 = *(const f32x4*)(p.sinT + (size_t)token * 16 + 8 * g + 4 * h);
#pragma unroll
        for (int e = 0; e < 4; ++e) {
          const float x1 = acc[2][0][4 * g + e], x2 = acc[2][0][4 * (g + 2) + e];
          acc[2][0][4 * g + e] = x1 * c4[e] - x2 * s4[e];
          acc[2][0][4 * (g + 2) + e] = x2 * c4[e] + x1 * s4[e];
        }
      }
      const float qs = LOG2E * 0.10206207261596577f;
      bf16_t* dst = p.Qm + ((size_t)(b * 8 + head) * S_ + s) * 96;
#pragma unroll
      for (int rb = 0; rb < 3; ++rb) {
        u32x2 w[4];
#pragma unroll
        for (int g = 0; g < 4; ++g) { w[g].x = pk_bf16(acc[rb][0][4 * g] * qs, acc[rb][0][4 * g + 1] * qs); w[g].y = pk_bf16(acc[rb][0][4 * g + 2] * qs, acc[rb][0][4 * g + 3] * qs); }
#pragma unroll
        for (int q = 0; q < 2; ++q) *(u32x4*)(dst + rb * 32 + 16 * q + 8 * h) = widen_pair(w[2 * q], w[2 * q + 1]);
      }
    } else {
      f32x16 acc[4][1];
      gemm_tile<128, 128, 1, 4, true, true>(p.WukvT + (size_t)head * 128 * 256, 256, p.CKV + (size_t)m0 * 256, 256, 256, smem, acc, sumsq);
      const float rstd = rsqrtf(sumsq[tl] * (1.f / 256) + 1e-6f);
      float kr[16];
#pragma unroll
      for (int g = 0; g < 4; ++g) {
        const f32x4 k4 = *(const f32x4*)(p.KR + (size_t)token * 32 + 8 * g + 4 * h);
#pragma unroll
        for (int e = 0; e < 4; ++e) kr[4 * g + e] = k4[e];
      }
      float ssq = 0.f;
#pragma unroll
      for (int rb = 0; rb < 2; ++rb)
#pragma unroll
        for (int i = 0; i < 16; ++i) { const float v = acc[rb][0][i] * rstd; acc[rb][0][i] = v; ssq += v * v; }
#pragma unroll
      for (int i = 0; i < 16; ++i) ssq += kr[i] * kr[i];
      ssq += __shfl_xor(ssq, 32);
      const float r2 = rsqrtf(ssq * (1.f / 96) + 1e-6f);
#pragma unroll
      for (int rb = 0; rb < 2; ++rb)
#pragma unroll
        for (int g = 0; g < 4; ++g) {
          const f32x4 w4 = *(const f32x4*)(p.khn + rb * 32 + 8 * g + 4 * h);
#pragma unroll
          for (int e = 0; e < 4; ++e) acc[rb][0][4 * g + e] *= r2 * w4[e];
        }
#pragma unroll
      for (int g = 0; g < 4; ++g) {
        const f32x4 w4 = *(const f32x4*)(p.khn + 64 + 8 * g + 4 * h);
#pragma unroll
        for (int e = 0; e < 4; ++e) kr[4 * g + e] *= r2 * w4[e];
      }
#pragma unroll
      for (int g = 0; g < 2; ++g) {
        const f32x4 c4 = *(const f32x4*)(p.cosT + (size_t)token * 16 + 8 * g + 4 * h), s4 = *(const f32x4*)(p.sinT + (size_t)token * 16 + 8 * g + 4 * h);
#pragma unroll
        for (int e = 0; e < 4; ++e) {
          const float x1 = kr[4 * g + e], x2 = kr[4 * (g + 2) + e];
          kr[4 * g + e] = x1 * c4[e] - x2 * s4[e];
          kr[4 * (g + 2) + e] = x2 * c4[e] + x1 * s4[e];
        }
      }
      bf16_t* dk = p.Km + ((size_t)(b * 8 + head) * S_ + s) * 96;
      bf16_t* dv = p.Vm + ((size_t)(b * 8 + head) * S_ + s) * 64;
#pragma unroll
      for (int rb = 0; rb < 2; ++rb) {
        u32x2 w[4], u[4];
#pragma unroll
        for (int g = 0; g < 4; ++g) {
          w[g].x = pk_bf16(acc[rb][0][4 * g], acc[rb][0][4 * g + 1]); w[g].y = pk_bf16(acc[rb][0][4 * g + 2], acc[rb][0][4 * g + 3]);
          u[g].x = pk_bf16(acc[rb + 2][0][4 * g] * rstd, acc[rb + 2][0][4 * g + 1] * rstd); u[g].y = pk_bf16(acc[rb + 2][0][4 * g + 2] * rstd, acc[rb + 2][0][4 * g + 3] * rstd);
        }
#pragma unroll
        for (int q = 0; q < 2; ++q) {
          *(u32x4*)(dk + rb * 32 + 16 * q + 8 * h) = widen_pair(w[2 * q], w[2 * q + 1]);
          *(u32x4*)(dv + rb * 32 + 16 * q + 8 * h) = widen_pair(u[2 * q], u[2 * q + 1]);
        }
      }
      {
        u32x2 w[4];
#pragma unroll
        for (int g = 0; g < 4; ++g) { w[g].x = pk_bf16(kr[4 * g], kr[4 * g + 1]); w[g].y = pk_bf16(kr[4 * g + 2], kr[4 * g + 3]); }
#pragma unroll
        for (int q = 0; q < 2; ++q) *(u32x4*)(dk + 64 + 16 * q + 8 * h) = widen_pair(w[2 * q], w[2 * q + 1]);
      }
    }
  }
}

template <int DQK, bool SB, bool SMAX>
DI void attn_item(const Params& p, char* smem, int bh, int qb, float Mb) {
  constexpr int KSTR = DQK + 8, VSTR = 72, NKS = DQK / 16, KCH = DQK / 8, KPT = 64 * KCH / 256, KBUF = 64 * KSTR, VBUF = 64 * VSTR;
  bf16_t* Ks = (bf16_t*)smem;
  bf16_t* Vs = Ks + 2 * KBUF;
  int* flags = (int*)(Vs + 2 * VBUF);
  const bf16_t* Qg = SB ? p.Qsb : p.Qm;
  const bf16_t* Kg = (SB ? p.Ksb : p.Km) + (size_t)bh * S_ * DQK;
  const bf16_t* Vg = (SB ? p.Vsb : p.Vm) + (size_t)bh * S_ * 64;
  const int tid = threadIdx.x, lane = tid & 63, wave = tid >> 6, r = lane & 31, h = lane >> 5;
  const int q0 = qb * 128, qw0 = q0 + wave * 32, query = qw0 + r;
  bf16x8 qf[NKS];
  {
    const bf16_t* qp = Qg + ((size_t)bh * S_ + query) * DQK + h * 8;
#pragma unroll
    for (int ks = 0; ks < NKS; ++ks) qf[ks] = *(const bf16x8*)(qp + ks * 16);
  }
  bf16x8 tri[2], ones;
#pragma unroll
  for (int s = 0; s < 2; ++s)
#pragma unroll
    for (int j = 0; j < 8; ++j) tri[s][j] = ((16 * s + 8 * (j >> 2) + 4 * h + (j & 3)) >= r) ? (short)0x3F80 : (short)0;
#pragma unroll
  for (int j = 0; j < 8; ++j) ones[j] = (short)0x3F80;

  const int nt = 2 * (qb + 1);
  f32x16 O[2];
#pragma unroll
  for (int db = 0; db < 2; ++db)
#pragma unroll
    for (int i = 0; i < 16; ++i) O[db][i] = 0.f;
  float m = -__builtin_huge_valf(), lsum = 0.f, carry = 0.f;
  f32x16 negM;
#pragma unroll
  for (int i = 0; i < 16; ++i) negM[i] = -Mb;

  u32x4 kreg[1][KPT], vreg[1][2];
#define AT_KB(IT) (SB ? 64 * (nt - 1 - (IT)) : 64 * (IT))
#define AT_LOAD(SET, IT) { const int kl_ = AT_KB(IT); \
    _Pragma("unroll") for (int i = 0; i < KPT; ++i) kreg[SET][i] = *(const u32x4*)(Kg + (size_t)kl_ * DQK + (tid + 256 * i) * 8); \
    _Pragma("unroll") for (int i = 0; i < 2; ++i) vreg[SET][i] = *(const u32x4*)(Vg + (size_t)kl_ * 64 + (tid + 256 * i) * 8); \
    __builtin_amdgcn_sched_barrier(0); }
#define AT_WRITE(SET, BUFI) { \
    _Pragma("unroll") for (int i = 0; i < KPT; ++i) { const int c = tid + 256 * i, row = c / KCH, kcol = c % KCH; *(u32x4*)(Ks + (BUFI) * KBUF + row * KSTR + kcol * 8) = kreg[SET][i]; } \
    _Pragma("unroll") for (int i = 0; i < 2; ++i) { const int c = tid + 256 * i; *(u32x4*)(Vs + (BUFI) * VBUF + (c >> 3) * VSTR + (c & 7) * 8) = vreg[SET][i]; } }
  const int blk = (lane >> 4) & 1, tq = (lane & 15) >> 2, tp = lane & 3;
  const int voff = (4 * h + tq) * VSTR + 16 * blk + 4 * tp;

  AT_LOAD(0, 0)
  AT_WRITE(0, 0)
  AT_LOAD(0, 1)
  __syncthreads();
  bool stop = false;
  for (int it2 = 0; it2 < nt && !stop; it2 += 2) {
#pragma unroll
   for (int st2 = 0; st2 < 2; ++st2) {
    const int it = it2 + st2;
    const int kb0 = AT_KB(it);
    const bf16_t* kc = Ks + st2 * KBUF;
    const bf16_t* vc = Vs + st2 * VBUF;
    const bool active = kb0 < qw0 + 32;
    f32x16 st[2];
    if (active) {
#pragma unroll
      for (int kb = 0; kb < 2; ++kb)
#pragma unroll
        for (int i = 0; i < 16; ++i) st[kb][i] = SMAX ? negM[i] : 0.f;
#pragma unroll
      for (int ks = 0; ks < NKS; ++ks)
#pragma unroll
        for (int kb = 0; kb < 2; ++kb) {
          const bf16x8 a = *(const bf16x8*)(kc + (kb * 32 + r) * KSTR + ks * 16 + h * 8);
          st[kb] = MFMA32(a, qf[ks], st[kb]);
        }
    }
    __builtin_amdgcn_sched_barrier(0);
    AT_WRITE(0, st2 ^ 1)
    AT_LOAD(0, (it + 2 < nt) ? it + 2 : nt - 1)
    if (active) {
      const bool diag = (kb0 + 64 > qw0);
      bf16x8 pk[4];
      if (!SB) {
        if (diag) {
#pragma unroll
          for (int kb = 0; kb < 2; ++kb)
#pragma unroll
            for (int i = 0; i < 16; ++i) { const int key = kb0 + kb * 32 + crow(i, h); if (key > query) st[kb][i] = -__builtin_huge_valf(); }
        }
        if (SMAX) {
          float ps = 0.f;
#pragma unroll
          for (int kb = 0; kb < 2; ++kb)
#pragma unroll
            for (int i = 0; i < 16; ++i) { const float pv = fast_exp2(st[kb][i]); st[kb][i] = pv; ps += pv; }
          lsum += ps;
        } else {
        float mx = st[0][0];
#pragma unroll
        for (int kb = 0; kb < 2; ++kb)
#pragma unroll
          for (int i = 0; i < 16; ++i) mx = fmaxf(mx, st[kb][i]);
        mx = fmaxf(mx, __shfl_xor(mx, 32));
        const float mnew = fmaxf(m, mx);
        const float alpha = fast_exp2(m - mnew);
        m = mnew;
        float ps = 0.f;
#pragma unroll
        for (int kb = 0; kb < 2; ++kb)
#pragma unroll
          for (int i = 0; i < 16; ++i) { const float pv = fast_exp2(st[kb][i] - mnew); st[kb][i] = pv; ps += pv; }
        lsum = lsum * alpha + ps;
#pragma unroll
        for (int db = 0; db < 2; ++db)
#pragma unroll
          for (int i = 0; i < 16; ++i) O[db][i] *= alpha;
        }
      } else {
        f32x16 ca[2];
        bf16x8 hi[4], lo[4];
        float tsum = 0.f;
#pragma unroll
        for (int kb = 0; kb < 2; ++kb)
#pragma unroll
          for (int i2 = 0; i2 < 8; ++i2) {
            float lk[2];
#pragma unroll
            for (int e = 0; e < 2; ++e) {
              const int i = 2 * i2 + e;
              const float z = fminf(st[kb][i], 100.f);
              const int key = kb0 + kb * 32 + crow(i, h);
              const bool valid = !diag || (key < query);
              float l = -fast_log2(1.f + fast_exp2(z));
              l = valid ? l : 0.f;
              lk[e] = l;
              tsum += l;
              ca[kb][i] = z + carry;
            }
            const unsigned hp = pk_bf16(lk[0], lk[1]);
            const unsigned lp = pk_bf16(lk[0] - bf_lo(hp), lk[1] - bf_hi(hp));
            const int kk = kb * 2 + (i2 >> 2), w = i2 & 3;
            hi[kk][2 * w] = (short)(hp & 0xffffu); hi[kk][2 * w + 1] = (short)(hp >> 16);
            lo[kk][2 * w] = (short)(lp & 0xffffu); lo[kk][2 * w + 1] = (short)(lp >> 16);
          }
        tsum += __shfl_xor(tsum, 32);
#pragma unroll
        for (int s = 0; s < 2; ++s) {
          ca[0] = MFMA32(tri[s], hi[s], ca[0]);
          ca[0] = MFMA32(tri[s], lo[s], ca[0]);
          ca[0] = MFMA32(ones, hi[2 + s], ca[0]);
          ca[0] = MFMA32(ones, lo[2 + s], ca[0]);
          ca[1] = MFMA32(tri[s], hi[2 + s], ca[1]);
          ca[1] = MFMA32(tri[s], lo[2 + s], ca[1]);
        }
#pragma unroll
        for (int kb = 0; kb < 2; ++kb)
#pragma unroll
          for (int i = 0; i < 16; ++i) {
            const int key = kb0 + kb * 32 + crow(i, h);
            const bool valid = !diag || (key < query);
            st[kb][i] = valid ? fast_exp2(ca[kb][i]) : 0.f;
          }
        carry += tsum;
      }
#pragma unroll
      for (int kb = 0; kb < 2; ++kb)
#pragma unroll
        for (int s = 0; s < 2; ++s) {
          u32x4 w;
#pragma unroll
          for (int e = 0; e < 4; ++e) w[e] = pk_bf16(st[kb][8 * s + 2 * e], st[kb][8 * s + 2 * e + 1]);
          pk[kb * 2 + s] = __builtin_bit_cast(bf16x8, w);
        }
#pragma unroll
      for (int kk = 0; kk < 4; ++kk)
#pragma unroll
        for (int db = 0; db < 2; ++db) {
          const s16x4 v0 = __builtin_amdgcn_ds_read_tr16_b64_v4i16((lds_s16x4*)(vc + voff + (16 * kk) * VSTR + 32 * db));
          const s16x4 v1 = __builtin_amdgcn_ds_read_tr16_b64_v4i16((lds_s16x4*)(vc + voff + (16 * kk + 8) * VSTR + 32 * db));
          const bf16x8 vf = __builtin_shufflevector(v0, v1, 0, 1, 2, 3, 4, 5, 6, 7);
          O[db] = MFMA32(vf, pk[kk], O[db]);
        }
    }
    if (SB) {
      const bool alive = __builtin_amdgcn_ballot_w64(carry > -64.f) != 0ull;
      if (lane == 0) flags[st2 * 4 + wave] = alive ? 1 : 0;
    }
    __syncthreads();
    if (SB) {
      const int any = flags[st2 * 4 + 0] | flags[st2 * 4 + 1] | flags[st2 * 4 + 2] | flags[st2 * 4 + 3];
      if (!any) { stop = true; break; }
    }
   }
  }
#undef AT_KB
#undef AT_LOAD
#undef AT_WRITE
  float inv = 1.f;
  if (!SB) { const float lt = lsum + __shfl_xor(lsum, 32); inv = 1.f / lt; }
  const size_t token = (size_t)(bh >> 3) * S_ + query;
  const int colbase = (SB ? 0 : 512) + (bh & 7) * 64;
#pragma unroll
  for (int db = 0; db < 2; ++db) {
    u32x2 w[4];
#pragma unroll
    for (int g = 0; g < 4; ++g) {
      const int col = colbase + db * 32 + 8 * g + 4 * h;
      const u32x2 gt = *(const u32x2*)(p.Gate + token * 1024 + col);
      w[g].x = pk_bf16(O[db][4 * g] * inv * bf_lo(gt.x), O[db][4 * g + 1] * inv * bf_hi(gt.x));
      w[g].y = pk_bf16(O[db][4 * g + 2] * inv * bf_lo(gt.y), O[db][4 * g + 3] * inv * bf_hi(gt.y));
    }
#pragma unroll
    for (int q = 0; q < 2; ++q) *(u32x4*)(p.Mixed + token * 1024 + colbase + db * 32 + 16 * q + 8 * h) = widen_pair(w[2 * q], w[2 * q + 1]);
  }
  __syncthreads();
}

DI void phase4(const Params& p, char* smem, const Sched sc) {
  int* s_item = (int*)(smem + LDS_BYTES - 16);
  float gq = 0.f, gk = 0.f;
  for (int i = 0; i < 96; ++i) { gq = fmaxf(gq, fabsf(p.qhn[i])); gk = fmaxf(gk, fabsf(p.khn[i])); }
  const float Mb = LOG2E * 9.797958971132712f * gq * gk * 1.02f;
  const bool smax = Mb < 56.f;
  for (int v = sc.xi; v < 8; v += sc.nx)
  for (;;) {
    if (threadIdx.x == 0) *s_item = (int)atomicAdd(&p.counters[XB_WQ(v)], 1u);
    __syncthreads();
    const int item = *s_item;
    __syncthreads();
    if (item >= 256) break;
    if (item < 128) {
      const int bh = 2 * v + (item & 1), qb = 63 - (item >> 1);
      if (smax) attn_item<96, false, true>(p, smem, bh, qb, Mb);
      else attn_item<96, false, false>(p, smem, bh, qb, 0.f);
    } else { const int j = item - 128; attn_item<64, true, false>(p, smem, 2 * v + (j & 1), 63 - (j >> 1), 0.f); }
  }
}

DI void phase5(const Params& p, char* smem, const Sched sc) {
  const int tid = threadIdx.x, lane = tid & 63, wave = tid >> 6, r = lane & 31, h = lane >> 5, wr = wave >> 1, wc = wave & 1;
  constexpr int CST = 132;
  float* ct = (float*)smem;
  for (int v = sc.xi; v < 8; v += sc.nx)
  for (int l = sc.rank; l < 16 * 8; l += sc.nloc) {
    const int g8 = l >> 6, rem = l & 63, nt = rem >> 3, mt = 16 * v + 8 * g8 + (rem & 7), m0 = mt * 128, n0 = nt * 128;
    f32x16 acc[2][2];
    gemm_tile<128, 128, 2, 2, false, true>(p.WoutT + (size_t)n0 * DM, DM, p.Mixed + (size_t)m0 * DM, DM, DM, smem, acc, nullptr);
    const int b = m0 >> 13;
#pragma unroll
    for (int mi = 0; mi < 2; ++mi)
#pragma unroll
      for (int ni = 0; ni < 2; ++ni)
#pragma unroll
        for (int g = 0; g < 4; ++g) {
          const f32x4 vv = {acc[mi][ni][4 * g], acc[mi][ni][4 * g + 1], acc[mi][ni][4 * g + 2], acc[mi][ni][4 * g + 3]};
          *(f32x4*)(ct + (wc * 64 + ni * 32 + r) * CST + wr * 64 + mi * 32 + 8 * g + 4 * h) = vv;
        }
    __syncthreads();
    const int c4 = (tid & 31) * 4, row0 = tid >> 5;
    const f32x4 gt = *(const f32x4*)(p.ada + b * 3072 + 2048 + n0 + c4);
#pragma unroll
    for (int half = 0; half < 2; ++half) {
      f32x4 xv[8];
#pragma unroll
      for (int j = 0; j < 8; ++j) xv[j] = *(const f32x4*)(p.x + (size_t)(m0 + row0 + 8 * (half * 8 + j)) * DM + n0 + c4);
#pragma unroll
      for (int j = 0; j < 8; ++j) {
        const int row = row0 + 8 * (half * 8 + j);
        const f32x4 cv = *(const f32x4*)(ct + row * CST + c4);
        f32x4 o;
#pragma unroll
        for (int e = 0; e < 4; ++e) o[e] = xv[j][e] + gt[e] * cv[e];
        *(f32x4*)(p.out + (size_t)(m0 + row) * DM + n0 + c4) = o;
      }
    }
    __syncthreads();
  }
}

#if !ONE_LAUNCH
template <int PH>
__global__ void __launch_bounds__(256, 2) k_phase(Params p) {
  __shared__ __attribute__((aligned(16))) char smem[LDS_BYTES];
  const int bid = blockIdx.x, nb = gridDim.x;
  Sched sc; sc.xi = bid & 7; sc.nx = 8; sc.rank = bid >> 3; sc.nloc = nb >> 3;
  if (PH == 0) phase0(p, smem, bid, nb);
  if (PH == 1) phase1(p, sc);
  if (PH == 2) phase2(p, smem, sc);
  if (PH == 3) phase3(p, smem, sc);
  if (PH == 4) phase4(p, smem, sc);
  if (PH == 5) phase5(p, smem, sc);
}

#else
__global__ void __launch_bounds__(256, 2) k_mega(Params p) {
  __shared__ __attribute__((aligned(16))) char smem[LDS_BYTES];
  __shared__ uint4 xb_words;
  if (p.out == nullptr) cg::this_grid().sync();
  const int bid = blockIdx.x, nb = gridDim.x;
  if (threadIdx.x == 0) xb_words = make_uint4(0u, 0u, 0u, 0u);
  __syncthreads();
  const XcdBarrier xb = xcd_barrier_post(p.counters, (volatile LAS unsigned*)&xb_words);
  phase0(p, smem, bid, nb);
  xcd_census(xb);
  xcd_barrier(xb);
  Sched sc; sc.nloc = (int)xb_words.x; sc.nx = (int)xb_words.y; sc.rank = (int)xb_words.z; sc.xi = (int)xb_words.w;
  if (__builtin_amdgcn_readfirstlane(sc.rank) * 2 >= __builtin_amdgcn_readfirstlane(sc.nloc)) __builtin_amdgcn_s_setprio(1);
  phase1(p, sc);
  xcd_local_barrier(xb);
  phase2(p, smem, sc);
  xcd_local_barrier(xb);
  phase3(p, smem, sc);
  xcd_barrier(xb);
  phase4(p, smem, sc);
  xcd_barrier(xb);
  phase5(p, smem, sc);
}

#endif

extern "C" void kernel_launch(void* const* d_in, const int* in_sizes, int n_in, void* d_out, int out_size, void* d_ws, size_t ws_size, hipStream_t stream) {
  Params p{};
  p.x = (const float*)d_in[0]; p.c = (const float*)d_in[1]; p.pos = (const int*)d_in[2];
  p.w_ada = (const float*)d_in[3]; p.b_ada = (const float*)d_in[4]; p.norm_w = (const float*)d_in[5]; p.w_in = (const float*)d_in[6];
  p.qln = (const float*)d_in[7]; p.w_uq = (const float*)d_in[8]; p.kvln = (const float*)d_in[9]; p.w_ukv = (const float*)d_in[10];
  p.qhn = (const float*)d_in[11]; p.khn = (const float*)d_in[12]; p.w_out = (const float*)d_in[13];
  p.out = (float*)d_out;
  char* w = (char*)d_ws;
  size_t off = 0;
  auto take = [&](size_t bytes) { char* q = w + off; off += (bytes + 255) & ~(size_t)255; return q; };
  p.ada = (float*)take(2 * 3072 * 4);
  p.counters = (unsigned*)take(XB_TOTAL_WORDS * 4);
  p.cosT = (float*)take((size_t)NTOK * 16 * 4);
  p.sinT = (float*)take((size_t)NTOK * 16 * 4);
  p.WinT = (bf16_t*)take((size_t)INPAD * 1024 * 2);
  p.WuqT = (bf16_t*)take((size_t)768 * 384 * 2);
  p.WukvT = (bf16_t*)take((size_t)1024 * 256 * 2);
  p.WoutT = (bf16_t*)take((size_t)1024 * 1024 * 2);
  p.H = (bf16_t*)take((size_t)NTOK * 1024 * 2);
  p.Qsb = (bf16_t*)take((size_t)NTOK * 512 * 2);
  p.Ksb = (bf16_t*)take((size_t)NTOK * 512 * 2);
  p.Vsb = (bf16_t*)take((size_t)NTOK * 512 * 2);
  p.Gate = (bf16_t*)take((size_t)NTOK * 1024 * 2);
  p.CQ = (bf16_t*)take((size_t)NTOK * 384 * 2);
  p.CKV = (bf16_t*)take((size_t)NTOK * 256 * 2);
  p.KR = (float*)take((size_t)NTOK * 32 * 4);
  p.Qm = (bf16_t*)take((size_t)NTOK * 768 * 2);
  p.Km = (bf16_t*)take((size_t)NTOK * 768 * 2);
  p.Vm = (bf16_t*)take((size_t)NTOK * 512 * 2);
  p.Mixed = p.H;
  hipMemsetAsync(p.counters, 0, XB_TOTAL_WORDS * 4, stream);
#if ONE_LAUNCH
  static int grid_blocks = 0;
  if (!grid_blocks) {
    int dev = 0, cus = 0, per_cu = 0;
    hipGetDevice(&dev);
    hipDeviceGetAttribute(&cus, hipDeviceAttributeMultiprocessorCount, dev);
    hipOccupancyMaxActiveBlocksPerMultiprocessor(&per_cu, k_mega, 256, 0);
    if (per_cu > 2) per_cu = 2;
    if (per_cu < 1) per_cu = 1;
    grid_blocks = cus * per_cu;
  }
  void* args[] = {&p};
  hipError_t e = hipLaunchCooperativeKernel((void*)k_mega, dim3(grid_blocks), dim3(256), args, 0, stream);
  if (e != hipSuccess) fprintf(stderr, "cooperative launch failed: %s (grid %d)\n", hipGetErrorString(e), grid_blocks);
#else
  const int G = 512;
#ifndef DUP_PHASE
#define DUP_PHASE -1
#endif
  k_phase<0><<<G, 256, 0, stream>>>(p);
  if (DUP_PHASE == 0) k_phase<0><<<G, 256, 0, stream>>>(p);
  k_phase<1><<<G, 256, 0, stream>>>(p);
  if (DUP_PHASE == 1) k_phase<1><<<G, 256, 0, stream>>>(p);
  k_phase<2><<<G, 256, 0, stream>>>(p);
  if (DUP_PHASE == 2) k_phase<2><<<G, 256, 0, stream>>>(p);
  k_phase<3><<<G, 256, 0, stream>>>(p);
  if (DUP_PHASE == 3) k_phase<3><<<G, 256, 0, stream>>>(p);
  k_phase<4><<<G, 256, 0, stream>>>(p);
  if (DUP_PHASE == 4) { hipMemsetAsync(p.counters, 0, XB_TOTAL_WORDS * 4, stream); k_phase<4><<<G, 256, 0, stream>>>(p); }
  k_phase<5><<<G, 256, 0, stream>>>(p);
  if (DUP_PHASE == 5) k_phase<5><<<G, 256, 0, stream>>>(p);
#endif
}
```
